# Optimizing an MI355X kernel written in HIP

```python
import jax
import jax.numpy as jnp
from jax import lax
import numpy as np

D_MODEL = 1024
BATCH = 1
SEQ = 16384
DEPTH = 2

N_MIXERS = 2
N_LAYERS_A = (DEPTH + 1) // 2
N_LAYERS_B = DEPTH // 2

A_HEADS = 16
A_HEAD_DIM = D_MODEL // A_HEADS
A_GROUPS = ((128, 1), (512, 4), (2048, 16))
A_N_GROUPS = len(A_GROUPS)
A_PAD = A_GROUPS[-1][0]
Q_BLOCK = 128

B_INNER = 2 * D_MODEL
B_HEADS = 4
B_HEAD_DIM = B_INNER // B_HEADS
B_CONV = 4
B_QKV_BLOCK = 4
B_CHUNK = 128

D_FF = 4 * D_MODEL
PLE_DIM = 256

EPS = 1e-6
NEG_INF = -1e30

kernel_name = 'hybrid_dilated_attn_mlstm_trunk'


def rms_norm(x, g):
    xf = x.astype(jnp.float32)
    y = xf * lax.rsqrt(jnp.mean(xf * xf, axis=-1, keepdims=True) + EPS)
    return (y * g.astype(jnp.float32)).astype(x.dtype)


def alibi_slopes(n):
    return jnp.asarray([2.0 ** (-8.0 * (h + 1) / n) for h in range(n)], jnp.float32)


def dilated_attention(h, w_qkv, q_gain, k_gain, w_o):
    B, S, _ = h.shape
    qkv = (h @ w_qkv).reshape(B, S, A_N_GROUPS, 3, A_HEADS, A_HEAD_DIM)
    q = rms_norm(qkv[:, :, :, 0], q_gain[:, None, :])
    k = rms_norm(qkv[:, :, :, 1], k_gain[:, None, :])
    v = qkv[:, :, :, 2]
    pad = ((0, 0), (A_PAD, 0), (0, 0), (0, 0))
    k_pads = [jnp.pad(k[:, :, g], pad) for g in range(A_N_GROUPS)]
    v_pads = [jnp.pad(v[:, :, g], pad) for g in range(A_N_GROUPS)]
    slopes = alibi_slopes(A_HEADS)
    scale = A_HEAD_DIM ** -0.5
    n_blocks = S // Q_BLOCK
    q_blocks = jnp.moveaxis(q.reshape(B, n_blocks, Q_BLOCK, A_N_GROUPS, A_HEADS, A_HEAD_DIM), 1, 0)

    def block(args):
        blk, qb = args
        t = blk * Q_BLOCK + jnp.arange(Q_BLOCK)
        lses, outs = [], []
        for g, (window, dil) in enumerate(A_GROUPS):
            n_keys = window // dil + 1
            dist = jnp.arange(n_keys) * dil
            pos = t[:, None] - dist[None, :]
            kg = jnp.take(k_pads[g], pos + A_PAD, axis=1)
            vg = jnp.take(v_pads[g], pos + A_PAD, axis=1)
            s = jnp.einsum('bqhd,bqjhd->bhqj', qb[:, :, g], kg).astype(jnp.float32) * scale
            s = s - slopes[:, None, None] * dist.astype(jnp.float32)
            s = jnp.where((pos >= 0)[None, None], s, NEG_INF)
            lse = jax.nn.logsumexp(s, axis=-1)
            pr = jnp.exp(s - lse[..., None]).astype(vg.dtype)
            outs.append(jnp.einsum('bhqj,bqjhd->bqhd', pr, vg))
            lses.append(lse)
        wgt = jax.nn.softmax(jnp.stack(lses, axis=0), axis=0)
        return jnp.einsum('gbhq,gbqhd->bqhd', wgt.astype(outs[0].dtype), jnp.stack(outs, axis=0))

    o = lax.map(block, (jnp.arange(n_blocks), q_blocks))
    o = jnp.moveaxis(o, 0, 1).reshape(B, S, D_MODEL)
    return o @ w_o


def causal_depthwise_conv(x, w, b):
    y = lax.conv_general_dilated(
        x, w[:, None, :].astype(x.dtype), window_strides=(1,),
        padding=((B_CONV - 1, 0),), dimension_numbers=('NWC', 'WIO', 'NWC'),
        feature_group_count=x.shape[-1])
    return y + b


def block_diag_proj(x, w):
    B, S, C = x.shape
    nb, blk, _ = w.shape
    return jnp.einsum('bsnj,njk->bsnk', x.reshape(B, S, nb, blk), w).reshape(B, S, C)


def mlstm_chunkwise(q, k, v, i_pre, f_pre):
    B, NH, S, DH = q.shape
    L = B_CHUNK
    NC = S // L
    k = k * DH ** -0.5
    logf = jax.nn.log_sigmoid(f_pre)

    def to_chunks(a):
        return jnp.moveaxis(a.reshape(B, NH, NC, L, *a.shape[3:]), 2, 0)

    causal = jnp.tril(jnp.ones((L, L), dtype=bool))

    def step(carry, inp):
        C, n, m = carry
        qt, kt, vt, it, lf = inp
        b = jnp.cumsum(lf, axis=-1)
        d_mat = jnp.where(causal, b[..., :, None] - b[..., None, :] + it[..., None, :], NEG_INF)
        inter = b + m[..., None]
        m_t = jnp.maximum(inter, jnp.max(d_mat, axis=-1))
        s = jnp.einsum('bhtd,bhsd->bhts', qt, kt) * jnp.exp(d_mat - m_t[..., None])
        sc = jnp.exp(inter - m_t)
        num = sc[..., None] * jnp.einsum('bhtd,bhde->bhte', qt, C) + jnp.einsum('bhts,bhse->bhte', s, vt)
        den = sc * jnp.einsum('bhtd,bhd->bht', qt, n) + jnp.sum(s, axis=-1)
        h = num / jnp.maximum(jnp.abs(den), jnp.exp(-m_t))[..., None]
        b_last = b[..., -1]
        g = b_last[..., None] - b + it
        m_new = jnp.maximum(b_last + m, jnp.max(g, axis=-1))
        decay = jnp.exp(b_last + m - m_new)
        wk = kt * jnp.exp(g - m_new[..., None])[..., None]
        C_new = decay[..., None, None] * C + jnp.einsum('bhsd,bhse->bhde', wk, vt)
        n_new = decay[..., None] * n + jnp.sum(wk, axis=2)
        return (C_new, n_new, m_new), h

    init = (jnp.zeros((B, NH, DH, DH), jnp.float32),
            jnp.zeros((B, NH, DH), jnp.float32),
            jnp.full((B, NH), NEG_INF, jnp.float32))
    _, hs = lax.scan(step, init, (to_chunks(q), to_chunks(k), to_chunks(v), to_chunks(i_pre), to_chunks(logf)))
    return jnp.moveaxis(hs, 0, 2).reshape(B, NH, S, DH)


def mlstm_mixer(h, w_up, conv_w, conv_b, w_q, w_k, w_v, w_gate, b_gate, h_gain, skip, w_down):
    B, S, _ = h.shape
    xz = h @ w_up
    xm, z = xz[..., :B_INNER], xz[..., B_INNER:]
    xc = jax.nn.silu(causal_depthwise_conv(xm, conv_w, conv_b))
    q = block_diag_proj(xc, w_q)
    k = block_diag_proj(xc, w_k)
    v = block_diag_proj(xm, w_v)
    gates = (jnp.concatenate([q, k, v], axis=-1) @ w_gate).astype(jnp.float32) + b_gate.astype(jnp.float32)
    i_pre = jnp.transpose(gates[..., :B_HEADS], (0, 2, 1))
    f_pre = jnp.transpose(gates[..., B_HEADS:], (0, 2, 1))

    def heads(a):
        return jnp.transpose(a.reshape(B, S, B_HEADS, B_HEAD_DIM), (0, 2, 1, 3)).astype(jnp.float32)

    hc = mlstm_chunkwise(heads(q), heads(k), heads(v), i_pre, f_pre)
    hc = rms_norm(jnp.transpose(hc, (0, 2, 1, 3)), h_gain.reshape(B_HEADS, B_HEAD_DIM))
    hc = hc.reshape(B, S, B_INNER).astype(h.dtype)
    out = (hc + skip * xc) * jax.nn.silu(z)
    return out @ w_down


def squared_relu_mlp(h, w1, w2):
    return jnp.square(jax.nn.relu(h @ w1)) @ w2


def setup_inputs(seed: int = 0) -> dict:
    key = jax.random.key(seed)
    keys = jax.random.split(key, 32)
    counter = [0]

    def nrm(shape, scale):
        kk = keys[counter[0]]
        counter[0] += 1
        return scale * jax.random.normal(kk, shape, jnp.float32)

    def gain(shape):
        return 1.0 + nrm(shape, 0.01)

    NA, NB = N_LAYERS_A, N_LAYERS_B
    n_blk = B_INNER // B_QKV_BLOCK
    f_bias = jnp.linspace(3.0, 6.0, B_HEADS, dtype=jnp.float32)
    return {
        'x': nrm((BATCH, SEQ, D_MODEL), 1.0),
        'p': nrm((DEPTH, BATCH, SEQ, PLE_DIM), 1.0),
        'a_norm': gain((NA, D_MODEL)),
        'a_w_qkv': nrm((NA, D_MODEL, A_N_GROUPS * 3 * D_MODEL), D_MODEL ** -0.5),
        'a_q_gain': gain((NA, A_N_GROUPS, A_HEAD_DIM)),
        'a_k_gain': gain((NA, A_N_GROUPS, A_HEAD_DIM)),
        'a_w_o': nrm((NA, D_MODEL, D_MODEL), D_MODEL ** -0.5),
        'b_norm': gain((NB, D_MODEL)),
        'b_w_up': nrm((NB, D_MODEL, 2 * B_INNER), D_MODEL ** -0.5),
        'b_conv_w': nrm((NB, B_CONV, B_INNER), B_CONV ** -0.5),
        'b_conv_b': nrm((NB, B_INNER), 0.01),
        'b_w_q': nrm((NB, n_blk, B_QKV_BLOCK, B_QKV_BLOCK), B_QKV_BLOCK ** -0.5),
        'b_w_k': nrm((NB, n_blk, B_QKV_BLOCK, B_QKV_BLOCK), B_QKV_BLOCK ** -0.5),
        'b_w_v': nrm((NB, n_blk, B_QKV_BLOCK, B_QKV_BLOCK), B_QKV_BLOCK ** -0.5),
        'b_w_gate': nrm((NB, 3 * B_INNER, 2 * B_HEADS), (3 * B_INNER) ** -0.5),
        'b_b_gate': jnp.concatenate([nrm((NB, B_HEADS), 0.1), f_bias[None, :] + nrm((NB, B_HEADS), 0.01)], axis=-1),
        'b_h_gain': gain((NB, B_INNER)),
        'b_skip': gain((NB, B_INNER)),
        'b_w_down': nrm((NB, B_INNER, D_MODEL), B_INNER ** -0.5),
        'mlp_norm': gain((DEPTH, D_MODEL)),
        'mlp_w1': nrm((DEPTH, D_MODEL, D_FF), D_MODEL ** -0.5),
        'mlp_w2': nrm((DEPTH, D_FF, D_MODEL), D_FF ** -0.5),
        'ple_norm': gain((DEPTH, D_MODEL)),
        'ple_w_gate': nrm((DEPTH, D_MODEL, D_MODEL), D_MODEL ** -0.5),
        'ple_w_proj': nrm((DEPTH, PLE_DIM, D_MODEL), PLE_DIM ** -0.5),
    }


def reference(x, p, a_norm, a_w_qkv, a_q_gain, a_k_gain, a_w_o,
              b_norm, b_w_up, b_conv_w, b_conv_b, b_w_q, b_w_k, b_w_v,
              b_w_gate, b_b_gate, b_h_gain, b_skip, b_w_down,
              mlp_norm, mlp_w1, mlp_w2, ple_norm, ple_w_gate, ple_w_proj):
    for i in range(DEPTH):
        j = i // N_MIXERS
        if i % N_MIXERS == 0:
            x = x + dilated_attention(rms_norm(x, a_norm[j]), a_w_qkv[j], a_q_gain[j], a_k_gain[j], a_w_o[j])
        else:
            x = x + mlstm_mixer(rms_norm(x, b_norm[j]), b_w_up[j], b_conv_w[j], b_conv_b[j],
                                b_w_q[j], b_w_k[j], b_w_v[j], b_w_gate[j], b_b_gate[j],
                                b_h_gain[j], b_skip[j], b_w_down[j])
        x = x + squared_relu_mlp(rms_norm(x, mlp_norm[i]), mlp_w1[i], mlp_w2[i])
        gate = jax.nn.sigmoid(rms_norm(x, ple_norm[i]) @ ple_w_gate[i])
        x = x + gate * (p[i] @ ple_w_proj[i])
    return x
```

```cpp
#include <hip/hip_runtime.h>
#include <hip/hip_cooperative_groups.h>
#include <cstdio>
namespace cg = cooperative_groups;

#ifndef MULTI_LAUNCH
#define MULTI_LAUNCH 0
#endif

#define LAS __attribute__((address_space(3)))
typedef unsigned short bf16_t;
typedef short bf16x8 __attribute__((ext_vector_type(8)));
typedef short s16x4 __attribute__((ext_vector_type(4)));
typedef float f32x4 __attribute__((ext_vector_type(4)));
typedef float f32x2 __attribute__((ext_vector_type(2)));
typedef float f32x16 __attribute__((ext_vector_type(16)));
typedef unsigned u32x4 __attribute__((ext_vector_type(4)));
typedef unsigned u32x2 __attribute__((ext_vector_type(2)));

#define GAS __attribute__((address_space(1)))
template <class T> __device__ __forceinline__ T* as_global(T* p) { return p; }
#define LDS_WAIT() asm volatile("s_waitcnt lgkmcnt(0)" ::: "memory")
#define BAR_LDS() do { asm volatile("s_waitcnt lgkmcnt(0)" ::: "memory"); __builtin_amdgcn_s_barrier(); asm volatile("" ::: "memory"); } while (0)

__device__ __forceinline__ unsigned cvt_pk_bf16(float lo, float hi) { unsigned r; asm("v_cvt_pk_bf16_f32 %0, %1, %2" : "=v"(r) : "v"(lo), "v"(hi)); return r; }
__device__ __forceinline__ float bf2f(unsigned short b) { return __uint_as_float(((unsigned)b) << 16); }
__device__ __forceinline__ float bflo(unsigned u) { return __uint_as_float(u << 16); }
__device__ __forceinline__ float bfhi(unsigned u) { return __uint_as_float(u & 0xffff0000u); }
__device__ __forceinline__ float wave_sum(float v) {
#pragma unroll
    for (int o = 1; o < 64; o <<= 1) v += __shfl_xor(v, o);
    return v;
}
__device__ __forceinline__ float wave_max(float v) {
#pragma unroll
    for (int o = 1; o < 64; o <<= 1) v = fmaxf(v, __shfl_xor(v, o));
    return v;
}
__device__ __forceinline__ f32x16 mfma32(bf16x8 a, bf16x8 b, f32x16 c) { return __builtin_amdgcn_mfma_f32_32x32x16_bf16(a, b, c, 0, 0, 0); }
typedef short v4i16_t __attribute__((ext_vector_type(4)));
__device__ __forceinline__ s16x4 tr_read(LAS const unsigned char* p) { return __builtin_bit_cast(s16x4, __builtin_amdgcn_ds_read_tr16_b64_v4i16((LAS v4i16_t*)p)); }
__device__ __forceinline__ bf16x8 cat8(s16x4 a, s16x4 b) { return (bf16x8){a[0], a[1], a[2], a[3], b[0], b[1], b[2], b[3]}; }
__device__ __forceinline__ f32x16 zero16() { f32x16 z;
#pragma unroll
    for (int i = 0; i < 16; ++i) z[i] = 0.f; return z; }

namespace pg8 {
constexpr int BM = 256, BK = 64, HALF = 128, HTB = HALF * BK * 2, STAGE_BYTES = 8 * HTB, NXCD = 8, WGM = 8;
__host__ __device__ __forceinline__ int lds_byte(int r, int c) { const int st = (r >> 4) * 2 + (c >> 5), rr = r & 15, cc = c & 31, ob = rr * 64 + cc * 2; return st * 1024 + (ob ^ (((ob >> 9) & 1) << 5)); }
__host__ __device__ __forceinline__ void stage_rc(int b, int& R, int& C) { const int st = b / 1024, sb = b % 1024, swz = sb ^ (((sb >> 9) & 1) << 5); R = (st >> 1) * 16 + swz / 64; C = (st & 1) * 32 + (swz % 64) / 2; }
__host__ __device__ __forceinline__ int perm32(int rho) { const int n = rho >> 4, i = rho & 15; return 8 * (i >> 2) + 4 * n + (i & 3); }
struct Unit { int pm, pn; };
struct Gemm { const bf16_t* A; const bf16_t* Bt; int M, N, K; };
struct StaticOrder {
    int nM, nN, nwg, G, c;
    __host__ __device__ void init(int M, int N, int G_, int c_) { nM = M / BM; nN = N / BM; nwg = nM * nN; G = G_; c = c_; }
    __host__ __device__ bool next(int i, Unit& u) const {
        const long L = (long)i * G + c; if (L >= nwg) return false;
        int wgid = (int)L; { const int q = nwg / NXCD, r = nwg % NXCD, xcd = wgid % NXCD, off = wgid / NXCD; wgid = (xcd < r ? xcd * (q + 1) : r * (q + 1) + (xcd - r) * q) + off; }
        const int nig = WGM * nN, gid = wgid / nig, fm = gid * WGM, gsz = (nM - fm) < WGM ? (nM - fm) : WGM;
        u.pm = fm + ((wgid % nig) % gsz); u.pn = (wgid % nig) / gsz; return true;
    }
    __device__ __forceinline__ void a_ready(const Unit&) const {}
    __device__ __forceinline__ void done(const Unit&) const {}
};

template <class Epi, class Sched>
__device__ __forceinline__ void gemm_phase(LAS unsigned char* lds, const int tid, const Gemm g, const Sched& S, const Epi& E) {
    const int wid = __builtin_amdgcn_readfirstlane(tid >> 6), lane = tid & 63, wr = wid >> 2, wc = wid & 3, fr = lane & 15, fq = lane >> 4;
    const int K = g.K, nt = K / BK;
    unsigned voffA[2], voffB[2];
#pragma unroll
    for (int i = 0; i < 2; ++i) { int R, C; stage_rc(tid * 16 + i * 8192, R, C); const int Rb = Epi::PERM ? ((R & ~31) + perm32(R & 31)) : R;
        voffA[i] = (unsigned)(R * K + C) * 2u; voffB[i] = (unsigned)(Rb * K + C) * 2u; }
    const size_t kstep = (size_t)(BK * 2);
    const size_t hstep = (size_t)HALF * K * 2;
    const size_t tstep = 2 * hstep;
    const unsigned ldsw = (unsigned)wid * 1024u;
    const int aoff = lds_byte(wr * 64 + fr, fq * 8), boff = lds_byte(wc * 32 + fr, fq * 8);
#define PG8_SA(b, h) (((b) * 2 + (h)) * HTB)
#define PG8_SB(b, h) ((4 + (b) * 2 + (h)) * HTB)
#define PG8_STAGE(bufoff, gbase, voff) do { _Pragma("unroll") for (int _i = 0; _i < 2; ++_i) \
        __builtin_amdgcn_global_load_lds((const unsigned*)((const char*)(gbase) + (voff)[_i]), (LAS unsigned*)(lds + (bufoff) + ldsw + _i * 8192), 16, 0, 0); } while (0)
#define PG8_LDA(dst, b, h) do { _Pragma("unroll") for (int m = 0; m < 4; ++m) _Pragma("unroll") for (int k = 0; k < 2; ++k) dst[m][k] = *(const LAS bf16x8*)(lds + PG8_SA(b, h) + aoff + m * 2048 + k * 1024); } while (0)
#define PG8_LDB(dst, b, h) do { _Pragma("unroll") for (int n = 0; n < 2; ++n) _Pragma("unroll") for (int k = 0; k < 2; ++k) dst[n][k] = *(const LAS bf16x8*)(lds + PG8_SB(b, h) + boff + n * 2048 + k * 1024); } while (0)
#define PG8_MMA(ai, bj, At, Bt) do { __builtin_amdgcn_s_setprio(1); _Pragma("unroll") for (int m = 0; m < 4; ++m) _Pragma("unroll") for (int n = 0; n < 2; ++n) _Pragma("unroll") for (int k = 0; k < 2; ++k) \
        acc[ai][bj][m][n] = __builtin_amdgcn_mfma_f32_16x16x32_bf16(Bt[n][k], At[m][k], acc[ai][bj][m][n], 0, 0, 0); __builtin_amdgcn_s_setprio(0); } while (0)
#define PG8_WAIT_V(n) asm volatile("s_waitcnt vmcnt(" #n ")" ::: "memory")
#define PG8_WAIT_L(n) asm volatile("s_waitcnt lgkmcnt(" #n ")" ::: "memory")
#define PG8_BAR __builtin_amdgcn_s_barrier()
#define PG8_SCHED __builtin_amdgcn_sched_barrier(0)
    Unit cur, nxt; int ui = 0;
    if (!S.next(0, cur)) return;
    f32x4 acc[2][2][4][2];
#pragma unroll
    for (int a = 0; a < 2; ++a)
#pragma unroll
        for (int b = 0; b < 2; ++b)
#pragma unroll
            for (int m = 0; m < 4; ++m)
#pragma unroll
                for (int n = 0; n < 2; ++n) acc[a][b][m][n] = (f32x4){0.f, 0.f, 0.f, 0.f};
    bf16x8 At[4][2], B0[2][2], B1[2][2];
    const char* cA = (const char*)g.A + (size_t)cur.pm * tstep; const char* cB = (const char*)g.Bt + (size_t)cur.pn * tstep;
    S.a_ready(cur);
    PG8_STAGE(PG8_SB(0, 0), cB, voffB); PG8_STAGE(PG8_SA(0, 0), cA, voffA); PG8_STAGE(PG8_SB(0, 1), cB + hstep, voffB); PG8_STAGE(PG8_SA(0, 1), cA + hstep, voffA);
    if (wr == 1) PG8_BAR;
    PG8_WAIT_V(4); PG8_BAR;
    PG8_STAGE(PG8_SB(1, 0), cB + kstep, voffB); PG8_STAGE(PG8_SA(1, 0), cA + kstep, voffA); PG8_STAGE(PG8_SB(1, 1), cB + hstep + kstep, voffB);
    PG8_WAIT_V(6); PG8_BAR;
    for (;;) {
        const bool has_next = S.next(ui + 1, nxt);
        const char* nA = has_next ? (const char*)g.A + (size_t)nxt.pm * tstep : cA; const char* nB = has_next ? (const char*)g.Bt + (size_t)nxt.pn * tstep : cB;
        for (int t = 0; t < nt; t += 2) {
            const bool last = (t == nt - 2);
            const char* a1 = cA + (size_t)(t + 1) * kstep;
            const char* a2 = last ? nA : cA + (size_t)(t + 2) * kstep; const char* b2 = last ? nB : cB + (size_t)(t + 2) * kstep;
            const char* a3 = a2 + kstep; const char* b3 = b2 + kstep;
            if (last && has_next) S.a_ready(nxt);
            PG8_LDB(B0, 0, 0); PG8_SCHED; PG8_LDA(At, 0, 0); PG8_STAGE(PG8_SA(1, 1), a1 + hstep, voffA);
            PG8_WAIT_L(8); PG8_BAR; PG8_WAIT_L(0); PG8_MMA(0, 0, At, B0); PG8_BAR; PG8_SCHED;
            PG8_LDB(B1, 0, 1); PG8_STAGE(PG8_SB(0, 0), b2, voffB);
            PG8_BAR; PG8_WAIT_L(0); PG8_MMA(0, 1, At, B1); PG8_BAR;
            PG8_LDA(At, 0, 1); PG8_STAGE(PG8_SA(0, 0), a2, voffA);
            PG8_BAR; PG8_WAIT_L(0); PG8_MMA(1, 0, At, B0); PG8_BAR; PG8_SCHED;
            PG8_STAGE(PG8_SB(0, 1), b2 + hstep, voffB);
            PG8_WAIT_V(6); PG8_BAR; PG8_MMA(1, 1, At, B1); PG8_BAR;
            PG8_LDB(B0, 1, 0); PG8_SCHED; PG8_LDA(At, 1, 0); PG8_STAGE(PG8_SA(0, 1), a2 + hstep, voffA);
            PG8_WAIT_L(8); PG8_BAR; PG8_WAIT_L(0); PG8_MMA(0, 0, At, B0); PG8_BAR; PG8_SCHED;
            PG8_LDB(B1, 1, 1); PG8_STAGE(PG8_SB(1, 0), b3, voffB);
            PG8_BAR; PG8_WAIT_L(0); PG8_MMA(0, 1, At, B1); PG8_BAR;
            PG8_LDA(At, 1, 1); PG8_STAGE(PG8_SA(1, 0), a3, voffA);
            PG8_BAR; PG8_WAIT_L(0); PG8_MMA(1, 0, At, B0); PG8_BAR; PG8_SCHED;
            PG8_STAGE(PG8_SB(1, 1), b3 + hstep, voffB);
            PG8_WAIT_V(6); PG8_BAR; PG8_MMA(1, 1, At, B1); PG8_BAR;
        }
        E(acc, cur, wr, wc, fr, fq); S.done(cur);
        if (!has_next) break;
#pragma unroll
        for (int a = 0; a < 2; ++a)
#pragma unroll
            for (int b = 0; b < 2; ++b)
#pragma unroll
                for (int m = 0; m < 4; ++m)
#pragma unroll
                    for (int n = 0; n < 2; ++n) acc[a][b][m][n] = (f32x4){0.f, 0.f, 0.f, 0.f};
        cur = nxt; cA = nA; cB = nB; ++ui;
    }
    PG8_WAIT_V(0);
    if (wr == 0) PG8_BAR;
    PG8_BAR;
#undef PG8_SA
#undef PG8_SB
#undef PG8_STAGE
#undef PG8_LDA
#undef PG8_LDB
#undef PG8_MMA
#undef PG8_WAIT_V
#undef PG8_WAIT_L
#undef PG8_BAR
#undef PG8_SCHED
}
}

typedef f32x4 AccT[2][2][4][2];

template <int ACT> struct EpiBf16 {
    static constexpr bool PERM = true;
    bf16_t* O; int ldc; int dsh; int Ltot;
    int split_tile; bf16_t* O2; size_t rowoff2;
    __device__ __forceinline__ void operator()(const AccT& acc, const pg8::Unit& u, int wr, int wc, int fr, int fq) const {
        const int row0 = u.pm * 256 + wr * 64 + fr; int colt = u.pn * 256; bf16_t* base = O;
        if (split_tile && u.pn >= split_tile) { base = O2; colt -= split_tile * 256; }
        const int col0 = colt + wc * 32 + 8 * fq;
        const int dm = (1 << dsh) - 1, L = Ltot >> dsh;
#pragma unroll
        for (int ai = 0; ai < 2; ++ai)
#pragma unroll
            for (int m = 0; m < 4; ++m) {
                const int r = row0 + ai * 128 + m * 16; const int dr = (r & dm) * L + (r >> dsh);
                bf16_t* rowp = base + (size_t)dr * ldc + col0;
#pragma unroll
                for (int bj = 0; bj < 2; ++bj) { f32x4 v0 = acc[ai][bj][m][0], v1 = acc[ai][bj][m][1];
                    if (ACT == 1) {
#pragma unroll
                        for (int e = 0; e < 4; ++e) { float a = fmaxf(v0[e], 0.f); v0[e] = a * a; float b = fmaxf(v1[e], 0.f); v1[e] = b * b; } }
                    u32x4 o; o.x = cvt_pk_bf16(v0[0], v0[1]); o.y = cvt_pk_bf16(v0[2], v0[3]); o.z = cvt_pk_bf16(v1[0], v1[1]); o.w = cvt_pk_bf16(v1[2], v1[3]);
                    *(u32x4*)(rowp + bj * 128) = o; }
            }
    }
};
template <int MODE> struct EpiF32 {
    static constexpr bool PERM = false;
    static constexpr int DEPTH = (MODE == 2) ? 2 : 3;
    float* C; const float* R; const float* PE; int ldc;
    __device__ __forceinline__ void operator()(const AccT& acc, const pg8::Unit& u, int wr, int wc, int fr, int fq) const {
        const int row0 = u.pm * 256 + wr * 64 + fr, col0 = u.pn * 256 + wc * 32 + 4 * fq;
        f32x4 rn[DEPTH][4]; u32x2 pn_[DEPTH][4];
        if (MODE != 0) {
#pragma unroll
            for (int d = 0; d < DEPTH; ++d) { const size_t ro = (size_t)(row0 + (d >> 2) * 128 + (d & 3) * 16) * ldc + col0;
#pragma unroll
                for (int q = 0; q < 4; ++q) { const size_t o = ro + (q >> 1) * 128 + (q & 1) * 16; rn[d][q] = *(const f32x4*)(R + o); if (MODE == 2) pn_[d][q] = *(const u32x2*)((const bf16_t*)PE + o); } }
        }
#pragma unroll
        for (int g8 = 0; g8 < 8; ++g8) { const int ai = g8 >> 2, m = g8 & 3, sl = g8 % DEPTH;
            const size_t ro = (size_t)(row0 + ai * 128 + m * 16) * ldc + col0;
            f32x4 rc[4]; u32x2 pc[4];
#pragma unroll
            for (int q = 0; q < 4; ++q) { rc[q] = rn[sl][q]; pc[q] = pn_[sl][q]; }
            if (MODE != 0 && g8 + DEPTH < 8) { const int ai2 = (g8 + DEPTH) >> 2, m2 = (g8 + DEPTH) & 3; const size_t ro2 = (size_t)(row0 + ai2 * 128 + m2 * 16) * ldc + col0;
#pragma unroll
                for (int q = 0; q < 4; ++q) { const size_t o = ro2 + (q >> 1) * 128 + (q & 1) * 16; rn[sl][q] = *(const f32x4*)(R + o); if (MODE == 2) pn_[sl][q] = *(const u32x2*)((const bf16_t*)PE + o); } }
#pragma unroll
            for (int q = 0; q < 4; ++q) { const int bj = q >> 1, n = q & 1; const size_t o = ro + bj * 128 + n * 16; f32x4 v = acc[ai][bj][m][n];
                if (MODE == 1) { v = v + rc[q]; }
                if (MODE == 2) { f32x4 pe; pe[0] = bflo(pc[q].x); pe[1] = bfhi(pc[q].x); pe[2] = bflo(pc[q].y); pe[3] = bfhi(pc[q].y);
#pragma unroll
                    for (int e = 0; e < 4; ++e) v[e] = rc[q][e] + pe[e] * __builtin_amdgcn_rcpf(1.f + __expf(-v[e])); }
                *(f32x4*)(C + o) = v; }
        }
    }
};

constexpr int S = 16384, DM = 1024, DFF = 4096, PLE = 256, BIN = 2048;
constexpr size_t MiB = (size_t)1 << 20;
constexpr size_t WS_MISC = 0;
constexpr size_t WS_W = 4 * MiB;
constexpr size_t W_QKV = WS_W, W_UP = WS_W, W_O = WS_W + 18 * MiB, W_DOWN = WS_W + 18 * MiB, W_1 = WS_W + 22 * MiB, W_2 = WS_W + 30 * MiB, W_G = WS_W + 38 * MiB, W_P = WS_W + 40 * MiB;
constexpr size_t WS_PB = 45 * MiB;
constexpr size_t WS_H = 60 * MiB;
constexpr size_t WS_QKV = 92 * MiB;
constexpr size_t WS_NACC = 188 * MiB;
constexpr size_t WS_Z = 252 * MiB;
constexpr size_t WS_HID = 92 * MiB;
constexpr size_t WS_PE = 92 * MiB;
constexpr size_t WS_END = 256 * MiB;
constexpr int LDS_BYTES = 147456;
constexpr float LOG2E = 1.4426950408889634f;

struct Params { const float* in[25]; float* out; unsigned char* ws; int ph_lo, ph_hi; };
enum { I_X = 0, I_P, I_ANORM, I_AWQKV, I_AQG, I_AKG, I_AWO, I_BNORM, I_BWUP, I_BCW, I_BCB, I_BWQ, I_BWK, I_BWV, I_BWG, I_BBG, I_BHG, I_BSKIP, I_BWDOWN, I_MNORM, I_MW1, I_MW2, I_PNORM, I_PWG, I_PWP };

__device__ __forceinline__ void ti_load(const float* W, int N, int item, int lane, float* r) {
    const int nblk = N / 32, kb = item / nblk, nb = item % nblk, k0 = 64 * kb, n0 = 32 * nb;
#pragma unroll
    for (int i = 0; i < 32; ++i) { const int kk = 2 * i + (lane >> 5); r[i] = W[(size_t)(k0 + kk) * N + n0 + (lane & 31)]; }
}
__device__ __forceinline__ void ti_put(const float* r, LAS float* scr, int lane) {
#pragma unroll
    for (int i = 0; i < 32; ++i) { const int kk = 2 * i + (lane >> 5); scr[kk * 33 + (lane & 31)] = r[i]; }
    LDS_WAIT();
}
__device__ __forceinline__ void ti_out(int K, int N, bf16_t* WT, LAS float* scr, int item, int lane) {
    const int nblk = N / 32, kb = item / nblk, nb = item % nblk, k0 = 64 * kb, n0 = 32 * nb;
    const int c = lane & 7;
#pragma unroll
    for (int j = 0; j < 4; ++j) { const int n = (lane >> 3) + 8 * j; const LAS float* s = scr + (8 * c) * 33 + n;
        u32x4 o; o.x = cvt_pk_bf16(s[0 * 33], s[1 * 33]); o.y = cvt_pk_bf16(s[2 * 33], s[3 * 33]); o.z = cvt_pk_bf16(s[4 * 33], s[5 * 33]); o.w = cvt_pk_bf16(s[6 * 33], s[7 * 33]);
        *(u32x4*)(WT + (size_t)(n0 + n) * K + k0 + 8 * c) = o; }
    LDS_WAIT();
}
__device__ __forceinline__ void convert_mat(const float* W, int K, int N, bf16_t* WT, LAS float* scr, int gw, int NGW, int lane) {
    const int nitems = (K / 64) * (N / 32);
    float r[32];
    if (gw < nitems) ti_load(W, N, gw, lane, r);
    for (int it = gw; it < nitems; it += NGW) {
        ti_put(r, scr, lane);
        if (it + NGW < nitems) ti_load(W, N, it + NGW, lane, r);
        ti_out(K, N, WT, scr, it, lane);
    }
}
__device__ __forceinline__ void convert_mat_np(const float* W, int K, int N, bf16_t* WT, LAS float* scr, int gw, int NGW, int lane) {
    const int nitems = (K / 64) * (N / 32);
    for (int it = gw; it < nitems; it += NGW) { float r[32]; ti_load(W, N, it, lane, r); ti_put(r, scr, lane); ti_out(K, N, WT, scr, it, lane); }
}
__device__ __forceinline__ void convert_flat(const float* src, bf16_t* dst, size_t n8, size_t gt, size_t ngt) {
    for (size_t i = gt; i < n8; i += ngt) { const f32x4 a = *(const f32x4*)(src + i * 8), b = *(const f32x4*)(src + i * 8 + 4);
        u32x4 o; o.x = cvt_pk_bf16(a[0], a[1]); o.y = cvt_pk_bf16(a[2], a[3]); o.z = cvt_pk_bf16(b[0], b[1]); o.w = cvt_pk_bf16(b[2], b[3]);
        *(u32x4*)(dst + i * 8) = o; }
}
template <int DEPTH>
__device__ __forceinline__ void norm_rows_d(const float* x, const float* gain, bf16_t* out, int nrows, int gw, int NGW, int lane) {
    f32x4 g[4];
#pragma unroll
    for (int j = 0; j < 4; ++j) g[j] = ((const f32x4*)gain)[lane + 64 * j];
    f32x4 nx[DEPTH][4];
#pragma unroll
    for (int d = 0; d < DEPTH; ++d) { const int m = gw + d * NGW; if (m < nrows) { const f32x4* xr = (const f32x4*)(x + (size_t)m * DM) + lane;
#pragma unroll
        for (int j = 0; j < 4; ++j) nx[d][j] = xr[64 * j]; } }
    for (int m0 = gw; m0 < nrows; m0 += DEPTH * NGW) {
#pragma unroll
        for (int d = 0; d < DEPTH; ++d) { const int m = m0 + d * NGW;
            if (m < nrows) {
                f32x4 v[4]; float s = 0.f;
#pragma unroll
                for (int j = 0; j < 4; ++j) v[j] = nx[d][j];
                const int mn = m + DEPTH * NGW;
                if (mn < nrows) { const f32x4* xr = (const f32x4*)(x + (size_t)mn * DM) + lane;
#pragma unroll
                    for (int j = 0; j < 4; ++j) nx[d][j] = xr[64 * j]; }
#pragma unroll
                for (int j = 0; j < 4; ++j) s += (v[j][0] * v[j][0] + v[j][1] * v[j][1]) + (v[j][2] * v[j][2] + v[j][3] * v[j][3]);
                const float rs = rsqrtf(wave_sum(s) * (1.f / DM) + 1e-6f);
                u32x2* o8 = (u32x2*)(out + (size_t)m * DM) + lane;
#pragma unroll
                for (int j = 0; j < 4; ++j) { u32x2 o; o.x = cvt_pk_bf16(v[j][0] * rs * g[j][0], v[j][1] * rs * g[j][1]); o.y = cvt_pk_bf16(v[j][2] * rs * g[j][2], v[j][3] * rs * g[j][3]); o8[64 * j] = o; }
            }
        }
    }
}
__device__ __forceinline__ void norm_rows(const float* x, const float* gain, bf16_t* out, int nrows, int gw, int NGW, int lane) { norm_rows_d<1>(x, gain, out, nrows, gw, NGW, lane); }

__device__ __forceinline__ void attn_phase(LAS unsigned char* lds, const int tid_, const bf16_t* qkv, int g, float* Nacc, float* Zacc, bf16_t* obuf,
                                           const float* q_gain, const float* k_gain, float M2) {
    const int dsh = 2 * g, dil = 1 << dsh, L = S >> dsh;
    constexpr int KP = 144, VP = 192;
    LAS unsigned char* Kl = lds; LAS unsigned char* Vl = lds + 384 * KP;
    const bool g256 = (gridDim.x == 256);
    const int nui = g256 ? 4 : (1024 + (int)gridDim.x - 1) / (int)gridDim.x;
    u32x4 kraw[6], vraw[6], qraw[4];
#define ATT_UNIT(UI) (g256 ? ((int)(blockIdx.x & 7) * 128 + (int)(blockIdx.x >> 3) * 4 + (UI)) : ((int)blockIdx.x + (UI) * (int)gridDim.x))
#define ATT_LOAD(UN) do { const int tid2 = tid_; const int hd_ = (UN) >> 6, rw_ = ((UN) & 63) * 256, cl_ = rw_ / L, ii_ = rw_ - cl_ * L; const int c_ = tid2 & 7; \
        _Pragma("unroll") for (int it = 0; it < 6; ++it) { const int rr = (tid2 >> 3) + 64 * it; const bool ok = (ii_ - 128 + rr) >= 0; \
            const size_t grow = ok ? (size_t)(rw_ - 128 + rr) : (size_t)rw_; const bf16_t* kp = qkv + zo_ + grow * 3072 + 1024 + hd_ * 64 + c_ * 8; \
            kraw[it] = *(const u32x4*)kp; vraw[it] = *(const u32x4*)(kp + 1024); } \
        const bf16_t* qp = qkv + zo_ + (size_t)(rw_ + 32 * (tid2 >> 6) + (tid2 & 31)) * 3072 + hd_ * 64 + 8 * ((tid2 >> 5) & 1); \
        _Pragma("unroll") for (int ks = 0; ks < 4; ++ks) qraw[ks] = *(const u32x4*)(qp + 16 * ks); } while (0)
    { size_t zo_ = 0; const int u0 = ATT_UNIT(0); if (u0 < 1024) ATT_LOAD(u0); }
    for (int ui = 0; ui < nui; ++ui) {
        const int u = ATT_UNIT(ui);
        if (u >= 1024) break;
        int tid = tid_; asm volatile("" : "+v"(tid));
        const int lane = tid & 63, wid = __builtin_amdgcn_readfirstlane(tid >> 6), r32 = lane & 31, hh = lane >> 5;
        const int head = u >> 6, qb = u & 63;
        const int row0 = qb * 256, cls = row0 / L, i0 = row0 - cls * L;
        const float slope2 = exp2f(-8.f * (float)(head + 1) / 16.f) * (float)dil * LOG2E;
        BAR_LDS();
        {
            const int c = tid & 7;
            float kg[8];
#pragma unroll
            for (int j = 0; j < 8; ++j) kg[j] = k_gain[g * 64 + c * 8 + j];
#pragma unroll
            for (int it = 0; it < 6; ++it) { const int rr = (tid >> 3) + 64 * it;
                const bool ok = (i0 - 128 + rr) >= 0;
                const u32x4 kv = kraw[it]; u32x4 vv = vraw[it];
                float f[8]; f[0] = bflo(kv.x); f[1] = bfhi(kv.x); f[2] = bflo(kv.y); f[3] = bfhi(kv.y); f[4] = bflo(kv.z); f[5] = bfhi(kv.z); f[6] = bflo(kv.w); f[7] = bfhi(kv.w);
                float ss = 0.f;
#pragma unroll
                for (int j = 0; j < 8; ++j) ss += f[j] * f[j];
                ss += __shfl_xor(ss, 1); ss += __shfl_xor(ss, 2); ss += __shfl_xor(ss, 4);
                const float rs = rsqrtf(ss * (1.f / 64.f) + 1e-6f);
                u32x4 ko; ko.x = cvt_pk_bf16(f[0] * rs * kg[0], f[1] * rs * kg[1]); ko.y = cvt_pk_bf16(f[2] * rs * kg[2], f[3] * rs * kg[3]);
                ko.z = cvt_pk_bf16(f[4] * rs * kg[4], f[5] * rs * kg[5]); ko.w = cvt_pk_bf16(f[6] * rs * kg[6], f[7] * rs * kg[7]);
                if (!ok) { ko = (u32x4){0u, 0u, 0u, 0u}; vv = (u32x4){0u, 0u, 0u, 0u}; }
                *(LAS u32x4*)(Kl + rr * KP + c * 16) = ko;
                *(LAS u32x4*)(Vl + rr * VP + c * 16) = vv;
            }
        }
        bf16x8 qf[4];
        {
            float ss = 0.f;
#pragma unroll
            for (int ks = 0; ks < 4; ++ks) {
                const float a0 = bflo(qraw[ks].x), a1 = bfhi(qraw[ks].x), a2 = bflo(qraw[ks].y), a3 = bfhi(qraw[ks].y), a4 = bflo(qraw[ks].z), a5 = bfhi(qraw[ks].z), a6 = bflo(qraw[ks].w), a7 = bfhi(qraw[ks].w);
                ss += (a0 * a0 + a1 * a1) + (a2 * a2 + a3 * a3) + (a4 * a4 + a5 * a5) + (a6 * a6 + a7 * a7); }
            ss += __shfl_xor(ss, 32);
            const float rs = rsqrtf(ss * (1.f / 64.f) + 1e-6f) * (0.125f * LOG2E);
#pragma unroll
            for (int ks = 0; ks < 4; ++ks) { const float* gp = q_gain + g * 64 + 16 * ks + 8 * hh;
                u32x4 o; o.x = cvt_pk_bf16(bflo(qraw[ks].x) * rs * gp[0], bfhi(qraw[ks].x) * rs * gp[1]); o.y = cvt_pk_bf16(bflo(qraw[ks].y) * rs * gp[2], bfhi(qraw[ks].y) * rs * gp[3]);
                o.z = cvt_pk_bf16(bflo(qraw[ks].z) * rs * gp[4], bfhi(qraw[ks].z) * rs * gp[5]); o.w = cvt_pk_bf16(bflo(qraw[ks].w) * rs * gp[6], bfhi(qraw[ks].w) * rs * gp[7]);
                qf[ks] = __builtin_bit_cast(bf16x8, o); }
        }
        { size_t zo_ = 0; asm volatile("" : "+v"(zo_)); const int un = ATT_UNIT(ui + 1); if (ui + 1 < nui && un < 1024) ATT_LOAD(un); }
        const int iq = i0 + 32 * wid + r32;
        const int t = iq * dil + cls;
        float* np = Nacc + (size_t)t * DM + head * 64;
        float* zp = Zacc + (size_t)t * 16 + head;
        f32x4 nold[8]; float zold = 0.f;
        if (g > 0) { zold = *zp;
#pragma unroll
            for (int i = 0; i < 8; ++i) nold[i] = *(const f32x4*)(np + 32 * (i >> 2) + 8 * (i & 3) + 4 * hh); }
        BAR_LDS();
        f32x16 o0 = zero16(), o1 = zero16(); float zsum = 0.f;
        unsigned zl = 0; asm volatile("" : "+v"(zl) :: "memory");
        const int trow = ((lane & 15) >> 2) + 4 * hh, tcol = 16 * ((lane >> 4) & 1) + 4 * (lane & 3);
#pragma unroll 1
        for (int kt = 0; kt < 5; ++kt) {
            const int kb = 32 * wid + 32 * kt;
            f32x16 s = zero16();
#pragma unroll
            for (int ks = 0; ks < 4; ++ks) { const bf16x8 kf = *(const LAS bf16x8*)(Kl + (kb + r32) * KP + (16 * ks + 8 * hh) * 2); s = mfma32(kf, qf[ks], s); }
            const int ikb = i0 - 128 + kb;
            float p[16];
            const float cl = slope2 * (float)(ikb + 4 * hh - iq) - M2;
            const bool need_mask = (kt == 0) || (kt == 4) || (ikb < 0);
            if (need_mask) {
#pragma unroll
                for (int r = 0; r < 16; ++r) { const int m = (r & 3) + 8 * (r >> 2) + 4 * hh; const int ik = ikb + m; const int j = iq - ik;
                    const bool valid = (j >= 0) && (j <= 128) && (ik >= 0);
                    const float lg = s[r] + (cl + slope2 * (float)((r & 3) + 8 * (r >> 2)));
                    p[r] = valid ? __builtin_amdgcn_exp2f(lg) : 0.f; zsum += p[r]; }
            } else {
#pragma unroll
                for (int r = 0; r < 16; ++r) { const float lg = s[r] + (cl + slope2 * (float)((r & 3) + 8 * (r >> 2)));
                    p[r] = __builtin_amdgcn_exp2f(lg); zsum += p[r]; }
            }
            u32x4 pa, pb;
            pa.x = cvt_pk_bf16(p[0], p[1]); pa.y = cvt_pk_bf16(p[2], p[3]); pa.z = cvt_pk_bf16(p[4], p[5]); pa.w = cvt_pk_bf16(p[6], p[7]);
            pb.x = cvt_pk_bf16(p[8], p[9]); pb.y = cvt_pk_bf16(p[10], p[11]); pb.z = cvt_pk_bf16(p[12], p[13]); pb.w = cvt_pk_bf16(p[14], p[15]);
            const bf16x8 pf0 = __builtin_bit_cast(bf16x8, pa), pf1 = __builtin_bit_cast(bf16x8, pb);
#pragma unroll
            for (int ksp = 0; ksp < 2; ++ksp) {
                const bf16x8 pf = ksp ? pf1 : pf0;
#pragma unroll
                for (int mt = 0; mt < 2; ++mt) {
                    LAS const unsigned char* a0 = Vl + zl + (kb + 16 * ksp + trow) * VP + (32 * mt + tcol) * 2;
                    const s16x4 lo = tr_read(a0), hi = tr_read(a0 + 8 * VP);
                    const bf16x8 vf = cat8(lo, hi);
                    if (mt == 0) o0 = mfma32(vf, pf, o0); else o1 = mfma32(vf, pf, o1);
                }
            }
        }
        asm volatile("" : "+v"(o0), "+v"(o1) :: "memory");
        zsum += __shfl_xor(zsum, 32);
        float zt = zsum;
        if (g > 0) zt += zold;
        if (g < 2) { if (hh == 0) *zp = zt; }
        const float zinv = __builtin_amdgcn_rcpf(zt);
#pragma unroll
        for (int mt = 0; mt < 2; ++mt)
#pragma unroll
            for (int rg = 0; rg < 4; ++rg) {
                const int dim = 32 * mt + 8 * rg + 4 * hh;
                f32x4 v;
#pragma unroll
                for (int e = 0; e < 4; ++e) v[e] = mt ? o1[4 * rg + e] : o0[4 * rg + e];
                if (g > 0) v = v + nold[mt * 4 + rg];
                if (g < 2) *(f32x4*)(np + dim) = v;
                else { u32x2 o; o.x = cvt_pk_bf16(v[0] * zinv, v[1] * zinv); o.y = cvt_pk_bf16(v[2] * zinv, v[3] * zinv); *(u32x2*)(obuf + (size_t)t * DM + head * 64 + dim) = o; }
            }
    }
}


constexpr size_t WS_CARRY = 12 * MiB;
constexpr size_t WS_XM = 26 * MiB;
constexpr size_t WS_XC = 43 * MiB;
constexpr size_t WS_QB = 59 * MiB;
constexpr size_t WS_KB = 75 * MiB;
constexpr size_t WS_VB = 91 * MiB;
constexpr size_t WS_ZG = 107 * MiB;
constexpr size_t WS_ST = 171 * MiB;
constexpr size_t WS_HSEG = 236 * MiB;
constexpr size_t MS_IPRE = 4096, MS_LOGF = 4096 + 262144, MS_NST = 1 * MiB, MS_MPREV = 2 * MiB, MS_MCARRY = 2 * MiB + 4096, MS_NCARRY = 3 * MiB;
constexpr int SEG = 4096, NSEG = 4, NCH = SEG / 128;
constexpr size_t MS_GFOLD = 3 * ((size_t)1 << 20) + 262144;
constexpr float KSCALE = 0.044194173824159216f;

__device__ __forceinline__ void unpack8(const u32x4 r, float* x) { x[0] = bflo(r.x); x[1] = bfhi(r.x); x[2] = bflo(r.y); x[3] = bfhi(r.y); x[4] = bflo(r.z); x[5] = bfhi(r.z); x[6] = bflo(r.w); x[7] = bfhi(r.w); }
__device__ __forceinline__ void load_w32(const float* w, float* W) {
#pragma unroll
    for (int i = 0; i < 8; ++i) { const f32x4 v = ((const f32x4*)w)[i]; W[4 * i] = v[0]; W[4 * i + 1] = v[1]; W[4 * i + 2] = v[2]; W[4 * i + 3] = v[3]; }
}
__device__ __forceinline__ u32x4 bd8(const u32x4 raw, const float* W, float scale) {
    float x[8]; unpack8(raw, x); float o[8];
#pragma unroll
    for (int b = 0; b < 2; ++b)
#pragma unroll
        for (int k = 0; k < 4; ++k) o[4 * b + k] = (x[4 * b] * W[16 * b + k] + x[4 * b + 1] * W[16 * b + 4 + k] + x[4 * b + 2] * W[16 * b + 8 + k] + x[4 * b + 3] * W[16 * b + 12 + k]) * scale;
    u32x4 r; r.x = cvt_pk_bf16(o[0], o[1]); r.y = cvt_pk_bf16(o[2], o[3]); r.z = cvt_pk_bf16(o[4], o[5]); r.w = cvt_pk_bf16(o[6], o[7]); return r;
}
__device__ __forceinline__ u32x4 bd8dot(const u32x4 raw, const float* W, float scale, const f32x4 na, const f32x4 nb, float& dot) {
    float x[8]; unpack8(raw, x); float o[8];
#pragma unroll
    for (int b = 0; b < 2; ++b)
#pragma unroll
        for (int k = 0; k < 4; ++k) o[4 * b + k] = (x[4 * b] * W[16 * b + k] + x[4 * b + 1] * W[16 * b + 4 + k] + x[4 * b + 2] * W[16 * b + 8 + k] + x[4 * b + 3] * W[16 * b + 12 + k]) * scale;
    dot += (o[0] * na[0] + o[1] * na[1]) + (o[2] * na[2] + o[3] * na[3]) + (o[4] * nb[0] + o[5] * nb[1]) + (o[6] * nb[2] + o[7] * nb[3]);
    u32x4 r; r.x = cvt_pk_bf16(o[0], o[1]); r.y = cvt_pk_bf16(o[2], o[3]); r.z = cvt_pk_bf16(o[4], o[5]); r.w = cvt_pk_bf16(o[6], o[7]); return r;
}
__device__ __forceinline__ float wave_scan_add(float v, int lane) {
#pragma unroll
    for (int o = 1; o < 64; o <<= 1) { const float n = __shfl_up(v, o); if (lane >= o) v += n; }
    return v;
}
__device__ __forceinline__ float wave_scan_max(float v, int lane) {
#pragma unroll
    for (int o = 1; o < 64; o <<= 1) { const float n = __shfl_up(v, o); if (lane >= o) v = fmaxf(v, n); }
    return v;
}

__device__ __forceinline__ void m2_fold(const int tid, const float* wq, const float* wk, const float* wv, const float* wgate, float* gfold) {
    const int c0 = 4 * tid;
    float Wq[16], Wk[16], Wv[16], Gc[4][8], Gvv[4][8];
#pragma unroll
    for (int i = 0; i < 4; ++i) { const f32x4 a = ((const f32x4*)(wq + tid * 16))[i], b = ((const f32x4*)(wk + tid * 16))[i], c = ((const f32x4*)(wv + tid * 16))[i];
#pragma unroll
        for (int e = 0; e < 4; ++e) { Wq[4 * i + e] = a[e]; Wk[4 * i + e] = b[e]; Wv[4 * i + e] = c[e]; } }
    {
    float Gq[4][8], Gk[4][8], Gv[4][8];
#pragma unroll
    for (int c = 0; c < 4; ++c)
#pragma unroll
        for (int h2 = 0; h2 < 2; ++h2) { const f32x4 a = *(const f32x4*)(wgate + (size_t)(c0 + c) * 8 + 4 * h2), b = *(const f32x4*)(wgate + (size_t)(BIN + c0 + c) * 8 + 4 * h2), d = *(const f32x4*)(wgate + (size_t)(2 * BIN + c0 + c) * 8 + 4 * h2);
#pragma unroll
            for (int e = 0; e < 4; ++e) { Gq[c][4 * h2 + e] = a[e]; Gk[c][4 * h2 + e] = b[e]; Gv[c][4 * h2 + e] = d[e]; } }
#pragma unroll
    for (int j = 0; j < 4; ++j)
#pragma unroll
        for (int gi = 0; gi < 8; ++gi) { float a = 0.f, b = 0.f;
#pragma unroll
            for (int k = 0; k < 4; ++k) { a += Wq[4 * j + k] * Gq[k][gi] + Wk[4 * j + k] * Gk[k][gi]; b += Wv[4 * j + k] * Gv[k][gi]; }
            Gc[j][gi] = a; Gvv[j][gi] = b; }
    }
#pragma unroll
    for (int j = 0; j < 4; ++j)
#pragma unroll
        for (int gi = 0; gi < 8; ++gi) { gfold[(size_t)(j * 8 + gi) * 512 + tid] = Gc[j][gi]; gfold[(size_t)(32 + j * 8 + gi) * 512 + tid] = Gvv[j][gi]; }
}

__device__ __forceinline__ void m2_phase(LAS unsigned char* lds, const int tid, const int bx, const int G, const int seg, const bf16_t* xm, bf16_t* xc, bf16_t* qo, bf16_t* ko, bf16_t* vo, float* ipre, float* logf,
                                         const float* conv_w, const float* conv_b, const float* wq, const float* wk, const float* wv, const float* gfold, const float* bgate) {
    const int lane = tid & 63, wid = tid >> 6, c0 = 4 * tid;
#define M2_STAGE(T0) do { LAS unsigned char* xs = lds + 8192; __syncthreads(); \
        _Pragma("unroll") for (int hb = 0; hb < 2; ++hb) { u32x4 rr[5]; \
        _Pragma("unroll") for (int i = 0; i < 5; ++i) { const int e = tid + 512 * (5 * hb + i); const int row = e >> 8, cq = e & 255; if (row < 19) rr[i] = *(const u32x4*)(xm + (size_t)((T0) + row) * BIN + 8 * cq); } \
        _Pragma("unroll") for (int i = 0; i < 5; ++i) { const int e = tid + 512 * (5 * hb + i); const int row = e >> 8, cq = e & 255; if (row < 19) *(LAS u32x4*)(xs + row * 4096 + cq * 16) = rr[i]; } } \
        __syncthreads(); } while (0)
    if (bx < SEG / 16) { M2_STAGE(((G == 256 && SEG / 16 == 256) ? ((bx & 7) * 32 + (bx >> 3)) : bx) * 16); }
    float cw[4][4], cb[4], Wq[16], Wk[16], Wv[16], Gc[4][8], Gvv[4][8];
#pragma unroll
    for (int k = 0; k < 4; ++k) { const f32x4 v = *(const f32x4*)(conv_w + k * BIN + c0); cw[k][0] = v[0]; cw[k][1] = v[1]; cw[k][2] = v[2]; cw[k][3] = v[3]; }
    { const f32x4 v = *(const f32x4*)(conv_b + c0); cb[0] = v[0]; cb[1] = v[1]; cb[2] = v[2]; cb[3] = v[3]; }
#pragma unroll
    for (int i = 0; i < 4; ++i) { const f32x4 a = ((const f32x4*)(wq + tid * 16))[i], b = ((const f32x4*)(wk + tid * 16))[i], c = ((const f32x4*)(wv + tid * 16))[i];
#pragma unroll
        for (int e = 0; e < 4; ++e) { Wq[4 * i + e] = a[e]; Wk[4 * i + e] = b[e]; Wv[4 * i + e] = c[e]; } }
#pragma unroll
    for (int j = 0; j < 4; ++j)
#pragma unroll
        for (int gi = 0; gi < 8; ++gi) { Gc[j][gi] = gfold[(size_t)(j * 8 + gi) * 512 + tid]; Gvv[j][gi] = gfold[(size_t)(32 + j * 8 + gi) * 512 + tid]; }
    LAS float* part = (LAS float*)lds;
    const int b0 = lane & 1, b1 = (lane >> 1) & 1, b2 = (lane >> 2) & 1, b3 = (lane >> 3) & 1, gidx4 = 8 * b0 + 4 * b1 + 2 * b2 + b3;
    for (int u = bx; u < SEG / 16; u += G) {
        const int t0 = ((G == 256 && SEG / 16 == 256) ? ((u & 7) * 32 + (u >> 3)) : u) * 16;
        if (u != bx) { M2_STAGE(t0); }
        LAS const unsigned char* xrow = lds + 8192 + c0 * 2;
#pragma unroll 1
        for (int tb = 0; tb < 16; tb += 2) {
            float gp[16];
#pragma unroll
            for (int j4 = 0; j4 < 2; ++j4) {
            const int tt = tb + j4;
            float x0[4], x1[4], x2[4], x3[4];
            { const u32x2 r0 = *(const LAS u32x2*)(xrow + tt * 4096), r1 = *(const LAS u32x2*)(xrow + (tt + 1) * 4096), r2 = *(const LAS u32x2*)(xrow + (tt + 2) * 4096), r3 = *(const LAS u32x2*)(xrow + (tt + 3) * 4096);
              x0[0] = bflo(r0.x); x0[1] = bfhi(r0.x); x0[2] = bflo(r0.y); x0[3] = bfhi(r0.y);
              x1[0] = bflo(r1.x); x1[1] = bfhi(r1.x); x1[2] = bflo(r1.y); x1[3] = bfhi(r1.y);
              x2[0] = bflo(r2.x); x2[1] = bfhi(r2.x); x2[2] = bflo(r2.y); x2[3] = bfhi(r2.y);
              x3[0] = bflo(r3.x); x3[1] = bfhi(r3.x); x3[2] = bflo(r3.y); x3[3] = bfhi(r3.y); }
            float xv[4];
#pragma unroll
            for (int c = 0; c < 4; ++c) { const float y = cb[c] + cw[0][c] * x0[c] + cw[1][c] * x1[c] + cw[2][c] * x2[c] + cw[3][c] * x3[c]; xv[c] = y * __builtin_amdgcn_rcpf(1.f + __expf(-y)); }
            { u32x2 o; o.x = cvt_pk_bf16(xv[0], xv[1]); o.y = cvt_pk_bf16(xv[2], xv[3]); *(u32x2*)(xc + (size_t)(t0 + tt) * BIN + c0) = o; }
            float q[4], kk[4], vv[4];
#pragma unroll
            for (int k = 0; k < 4; ++k) { q[k] = xv[0] * Wq[k] + xv[1] * Wq[4 + k] + xv[2] * Wq[8 + k] + xv[3] * Wq[12 + k];
                kk[k] = xv[0] * Wk[k] + xv[1] * Wk[4 + k] + xv[2] * Wk[8 + k] + xv[3] * Wk[12 + k];
                vv[k] = x3[0] * Wv[k] + x3[1] * Wv[4 + k] + x3[2] * Wv[8 + k] + x3[3] * Wv[12 + k]; }
            { const size_t o = (size_t)(t0 + tt) * BIN + c0; u32x2 w;
              w.x = cvt_pk_bf16(q[0], q[1]); w.y = cvt_pk_bf16(q[2], q[3]); *(u32x2*)(qo + o) = w;
              w.x = cvt_pk_bf16(kk[0] * KSCALE, kk[1] * KSCALE); w.y = cvt_pk_bf16(kk[2] * KSCALE, kk[3] * KSCALE); *(u32x2*)(ko + o) = w;
              w.x = cvt_pk_bf16(vv[0], vv[1]); w.y = cvt_pk_bf16(vv[2], vv[3]); *(u32x2*)(vo + o) = w; }
#pragma unroll
            for (int gi = 0; gi < 8; ++gi) { float a = 0.f;
#pragma unroll
                for (int c = 0; c < 4; ++c) a += xv[c] * Gc[c][gi] + x3[c] * Gvv[c][gi];
                gp[j4 * 8 + gi] = a; }
            }
            float h8[8], h4[4], h2[2], a1;
#pragma unroll
            for (int i = 0; i < 8; ++i) { const float send = b0 ? gp[i] : gp[8 + i]; const float recv = __shfl_xor(send, 1); h8[i] = (b0 ? gp[8 + i] : gp[i]) + recv; }
#pragma unroll
            for (int i = 0; i < 4; ++i) { const float send = b1 ? h8[i] : h8[4 + i]; const float recv = __shfl_xor(send, 2); h4[i] = (b1 ? h8[4 + i] : h8[i]) + recv; }
#pragma unroll
            for (int i = 0; i < 2; ++i) { const float send = b2 ? h4[i] : h4[2 + i]; const float recv = __shfl_xor(send, 4); h2[i] = (b2 ? h4[2 + i] : h4[i]) + recv; }
            { const float send = b3 ? h2[0] : h2[1]; const float recv = __shfl_xor(send, 8); a1 = (b3 ? h2[1] : h2[0]) + recv; }
            a1 += __shfl_xor(a1, 16); a1 += __shfl_xor(a1, 32);
            if (lane < 16) part[((tb + (gidx4 >> 3)) * 8 + wid) * 8 + (gidx4 & 7)] = a1;
        }
        __syncthreads();
        if (tid < 128) { const int tok = tid >> 3, gi = tid & 7; float v = bgate[gi];
#pragma unroll
            for (int w = 0; w < 8; ++w) v += part[(tok * 8 + w) * 8 + gi];
            const size_t tg = (size_t)seg * SEG + t0 + tok;
            if (gi < 4) ipre[tg * 4 + gi] = v; else logf[tg * 4 + gi - 4] = fminf(v, 0.f) - log1pf(__expf(-fabsf(v))); }
        __syncthreads();
    }
}

__device__ __forceinline__ u32x4 scale8(const u32x4 r, float w) {
    u32x4 o; o.x = cvt_pk_bf16(bflo(r.x) * w, bfhi(r.x) * w); o.y = cvt_pk_bf16(bflo(r.y) * w, bfhi(r.y) * w);
    o.z = cvt_pk_bf16(bflo(r.z) * w, bfhi(r.z) * w); o.w = cvt_pk_bf16(bflo(r.w) * w, bfhi(r.w) * w); return o;
}
__device__ __forceinline__ void m3_phase(LAS unsigned char* lds, const int tid_, const int bx, const int G, const int seg, const bf16_t* kb, const bf16_t* vb, const float* ipre, const float* logf,
                                         bf16_t* states, float* nstates, float* mprev_g, float* mcarry, float* carryC, float* ncarry) {
    constexpr int KP = 144;
    LAS float* a_s = (LAS float*)lds;
    LAS float* bl = (LAS float*)(lds + 32768); LAS float* am = bl + 64; LAS float* Al = bl + 128; LAS float* dec = bl + 192;
    LAS unsigned char* Kt = lds + 36864;
    for (int u = bx; u < 256; u += G) {
        int tid = tid_; asm volatile("" : "+v"(tid));
        const int lane = tid & 63, wid = __builtin_amdgcn_readfirstlane(tid >> 6), r32 = lane & 31, hh = lane >> 5;
        const int xcd = u & 7, idx = u >> 3;
        const int head = xcd >> 1, dt = (xcd & 1) * 4 + (idx >> 3), et = idx & 7;
        __syncthreads();
        for (int c = wid; c < NCH; c += 8) {
            const size_t tg = (size_t)seg * SEG + c * 128 + 2 * lane;
            const float lf0 = logf[tg * 4 + head], lf1 = logf[(tg + 1) * 4 + head], i0 = ipre[tg * 4 + head], i1 = ipre[(tg + 1) * 4 + head];
            const float ps = lf0 + lf1; const float incl = wave_scan_add(ps, lane);
            const float bb0 = incl - lf1, bb1 = incl; const float a0 = i0 - bb0, a1 = i1 - bb1;
            const float amax = wave_max(fmaxf(a0, a1)); const float blast = __shfl(incl, 63);
            a_s[c * 128 + 2 * lane] = a0; a_s[c * 128 + 2 * lane + 1] = a1;
            if (lane == 0) { bl[c] = blast; am[c] = amax; }
        }
        __syncthreads();
        if (wid == 0) {
            const float amr = (lane < NCH) ? am[lane] : 0.f, blr = (lane < NCH) ? bl[lane] : 0.f;
            float m = (seg == 0) ? -1e30f : mcarry[4 * seg + head];
            m = __int_as_float(__builtin_amdgcn_readfirstlane(__float_as_int(m)));
            float myA = 0.f, myd = 0.f, mym = 0.f;
#pragma unroll
            for (int c = 0; c < NCH; ++c) { const float amc = __int_as_float(__builtin_amdgcn_readlane(__float_as_int(amr), c)), blc = __int_as_float(__builtin_amdgcn_readlane(__float_as_int(blr), c));
                const float A = fmaxf(m, amc); const float d = __expf(m - A);
                if (lane == c) { myA = A; myd = d; mym = m; }
                m = blc + A; }
            if (lane < NCH) { Al[lane] = myA; dec[lane] = myd; if (dt == 0 && et == 0) mprev_g[(seg * NCH + lane) * 4 + head] = mym; }
            if (lane == 0 && dt == 0 && et == 0 && seg + 1 < NSEG) mcarry[4 * (seg + 1) + head] = m;
        }
        __syncthreads();
        const int cc = tid & 7, rowp = tid >> 3;
        const int kch = head * 512 + dt * 64 + 8 * cc, vch = head * 512 + et * 64 + 8 * cc;
        const int mt = wid & 1, nt = (wid >> 1) & 1; const bool do_n = (et == 0) && (wid < 2);
        f32x16 accC = zero16(), nacc = zero16();
        const int dbase = dt * 64 + 32 * mt + 4 * hh, ecol = et * 64 + 32 * nt + r32;
        if (seg > 0 && wid < 4) {
#pragma unroll
            for (int r = 0; r < 16; ++r) { const int d = dbase + (r & 3) + 8 * (r >> 2); accC[r] = carryC[((size_t)head * 512 + d) * 512 + ecol]; if (do_n) nacc[r] = ncarry[head * 512 + d]; }
        }
        bf16x8 ones;
#pragma unroll
        for (int i = 0; i < 8; ++i) ones[i] = (short)0x3F80;
        const int q4 = (lane & 15) >> 2, tcol = 16 * ((lane >> 4) & 1) + 4 * (lane & 3);
        LAS unsigned char* Sn = lds + 110592;
        if (wid < 4) {
#pragma unroll
            for (int r = 0; r < 16; ++r) { const int dl = 32 * mt + 4 * hh + (r & 3) + 8 * (r >> 2);
                *(LAS unsigned short*)(Sn + dl * KP + (32 * nt + r32) * 2) = (unsigned short)(cvt_pk_bf16(accC[r], 0.f) & 0xffffu); }
        }
        const bf16_t* xk0 = kb + (size_t)rowp * BIN + kch; const bf16_t* xv0 = vb + (size_t)rowp * BIN + vch;
        u32x4 pk[4][2], pv[4][2];
#pragma unroll
        for (int j = 0; j < 4; ++j)
#pragma unroll
            for (int hf = 0; hf < 2; ++hf) { pk[j][hf] = *(const u32x4*)(xk0 + (size_t)(128 * j + 64 * hf) * BIN); pv[j][hf] = *(const u32x4*)(xv0 + (size_t)(128 * j + 64 * hf) * BIN); }
#pragma unroll 1
        for (int c4 = 0; c4 < NCH; c4 += 4) {
#pragma unroll
          for (int j = 0; j < 4; ++j) {
            const int c = c4 + j;
            size_t zo = 0; asm volatile("" : "+v"(zo));
            LAS unsigned char* Kb = Kt + (c & 1) * (256 * KP); LAS unsigned char* Vb = Kb + 128 * KP;
            const float Ac = Al[c];
#pragma unroll
            for (int hf = 0; hf < 2; ++hf) { const int row = rowp + 64 * hf;
                const float wsc = __expf(a_s[c * 128 + row] - Ac);
                *(LAS u32x4*)(Kb + row * KP + cc * 16) = scale8(pk[j][hf], wsc);
                *(LAS u32x4*)(Vb + row * KP + cc * 16) = pv[j][hf]; }
            const int cn = (c + 4 < NCH) ? c + 4 : NCH - 1;
#pragma unroll
            for (int hf = 0; hf < 2; ++hf) {
                pk[j][hf] = *(const u32x4*)(xk0 + zo + (size_t)(cn * 128 + 64 * hf) * BIN); pv[j][hf] = *(const u32x4*)(xv0 + zo + (size_t)(cn * 128 + 64 * hf) * BIN); }
            BAR_LDS();
            {   const u32x4 sv = *(const LAS u32x4*)(Sn + (c & 1) * (64 * KP) + rowp * KP + cc * 16);
                *(u32x4*)(states + zo + ((size_t)(c * 4 + head) * 512 + dt * 64 + rowp) * 512 + et * 64 + cc * 8) = sv; }
            if (wid < 4) {
                if (do_n && r32 == 0) {
#pragma unroll
                    for (int r = 0; r < 16; ++r) { const int d = dbase + (r & 3) + 8 * (r >> 2); nstates[(size_t)(c * 4 + head) * 512 + d] = nacc[r]; } }
                unsigned zl = 0; asm volatile("" : "+v"(zl) :: "memory");
                const float dc = dec[c];
#pragma unroll
                for (int r = 0; r < 16; ++r) { accC[r] *= dc; nacc[r] *= dc; }
#pragma unroll
                for (int ks = 0; ks < 8; ++ks) {
                    LAS const unsigned char* ka = Kb + zl + (16 * ks + 8 * hh + q4) * KP + (32 * mt + tcol) * 2;
                    LAS const unsigned char* va = Vb + zl + (16 * ks + 8 * hh + q4) * KP + (32 * nt + tcol) * 2;
                    const bf16x8 af = cat8(tr_read(ka), tr_read(ka + 4 * KP));
                    const bf16x8 bf = cat8(tr_read(va), tr_read(va + 4 * KP));
                    accC = mfma32(af, bf, accC);
                    nacc = mfma32(af, ones, nacc);
                }
                asm volatile("" : "+v"(accC), "+v"(nacc) :: "memory");
                LAS unsigned char* Sw = Sn + ((c + 1) & 1) * (64 * KP);
#pragma unroll
                for (int r = 0; r < 16; ++r) { const int dl = 32 * mt + 4 * hh + (r & 3) + 8 * (r >> 2);
                    *(LAS unsigned short*)(Sw + dl * KP + (32 * nt + r32) * 2) = (unsigned short)(cvt_pk_bf16(accC[r], 0.f) & 0xffffu); }
            }
          }
        }
        if (seg + 1 < NSEG && wid < 4) {
#pragma unroll
            for (int r = 0; r < 16; ++r) { const int d = dbase + (r & 3) + 8 * (r >> 2); carryC[((size_t)head * 512 + d) * 512 + ecol] = accC[r]; if (do_n && r32 == 0) ncarry[head * 512 + d] = nacc[r]; }
        }
    }
}

__device__ __forceinline__ void m4_phase(LAS unsigned char* lds, const int tid_, const int bx, const int G, const int seg, const bf16_t* qb, const bf16_t* kb, const bf16_t* vb, const bf16_t* xc, bf16_t* zg,
                                         const float* ipre, const float* logf, const bf16_t* states, const float* nstates, const float* mprev_g, const float* hgain, const float* skip) {
    constexpr int KP = 144, PP = 272, BP = 1088;
    LAS float* sa = (LAS float*)lds; LAS float* sA = sa + 128; LAS float* smt = sa + 256; LAS float* ssc = sa + 384; LAS float* sden = sa + 512; LAS float* sssq = sa + 640; LAS float* sdenp = sa + 1152;
    LAS unsigned char* PL = lds + 8192; LAS unsigned char* QS = lds + 43008; LAS unsigned char* KS = lds + 61440; LAS unsigned char* BT = lds + 61440;
    for (int u = bx; u < NCH * 8; u += G) {
        int tid = tid_; asm volatile("" : "+v"(tid));
        const int lane = tid & 63, wid = __builtin_amdgcn_readfirstlane(tid >> 6), r32 = lane & 31, hh = lane >> 5;
        const int q4 = (lane & 15) >> 2, tcol = 16 * ((lane >> 4) & 1) + 4 * (lane & 3);
        const bool xmap = (G == 256 && NCH * 8 == 256);
        const int xq = u & 7, jq = u >> 3, pairidx = xq * 16 + (jq >> 1);
        const int half = xmap ? (jq & 1) : (u & 1), c = xmap ? (pairidx >> 2) : (u >> 3), head = xmap ? (pairidx & 3) : ((u >> 1) & 3);
        const size_t rbase = (size_t)c * 128;
        __syncthreads();
        if (wid == 0) {
            const size_t tg = (size_t)seg * SEG + c * 128 + 2 * lane;
            const float lf0 = logf[tg * 4 + head], lf1 = logf[(tg + 1) * 4 + head], i0 = ipre[tg * 4 + head], i1 = ipre[(tg + 1) * 4 + head];
            const float incl = wave_scan_add(lf0 + lf1, lane);
            const float bb0 = incl - lf1, bb1 = incl; const float a0 = i0 - bb0, a1 = i1 - bb1;
            const float mp = mprev_g[(seg * NCH + c) * 4 + head];
            const float inclm = wave_scan_max(fmaxf(a0, a1), lane); float exclm = __shfl_up(inclm, 1); if (lane == 0) exclm = -3e38f;
            const float A0 = fmaxf(mp, fmaxf(exclm, a0)), A1 = fmaxf(mp, inclm);
            sa[2 * lane] = a0; sa[2 * lane + 1] = a1; sA[2 * lane] = A0; sA[2 * lane + 1] = A1; smt[2 * lane] = bb0 + A0; smt[2 * lane + 1] = bb1 + A1;
            ssc[2 * lane] = __expf(mp - A0); ssc[2 * lane + 1] = __expf(mp - A1);
            sdenp[2 * lane] = 0.f; sdenp[2 * lane + 1] = 0.f;
        }
        __syncthreads();
        const int cc = tid & 7, rowp = tid >> 3;
        const int trow = 64 * half + rowp;
        const int chh = head * 512 + 8 * cc;
        {
            const int st = wid & 3, tt = 2 * half + (wid >> 2);
            f32x16 s0 = zero16();
            u32x4 rq = *(const u32x4*)(qb + (rbase + trow) * BIN + chh), rk0 = *(const u32x4*)(kb + (rbase + rowp) * BIN + chh), rk1 = *(const u32x4*)(kb + (rbase + rowp + 64) * BIN + chh);
#pragma unroll 1
            for (int ds_ = 0; ds_ < 8; ++ds_) {
                int ds = ds_; asm volatile("" : "+s"(ds));
                size_t zo = 0; asm volatile("" : "+v"(zo));
                *(LAS u32x4*)(QS + rowp * KP + cc * 16) = rq;
                *(LAS u32x4*)(KS + rowp * KP + cc * 16) = rk0;
                *(LAS u32x4*)(KS + (rowp + 64) * KP + cc * 16) = rk1;
                { const int dn = (ds + 1 < 8) ? ds + 1 : 7;
                  rq = *(const u32x4*)(qb + zo + (rbase + trow) * BIN + chh + dn * 64);
                  rk0 = *(const u32x4*)(kb + zo + (rbase + rowp) * BIN + chh + dn * 64);
                  rk1 = *(const u32x4*)(kb + zo + (rbase + rowp + 64) * BIN + chh + dn * 64); }
                BAR_LDS();
#pragma unroll
                for (int ks = 0; ks < 4; ++ks) { const bf16x8 kf = *(const LAS bf16x8*)(KS + (32 * st + r32) * KP + (16 * ks + 8 * hh) * 2);
                    const bf16x8 q0 = *(const LAS bf16x8*)(QS + (32 * (wid >> 2) + r32) * KP + (16 * ks + 8 * hh) * 2);
                    s0 = mfma32(kf, q0, s0); }
                BAR_LDS();
            }
            { const int t = 32 * tt + r32; const float At = sA[t]; float psum = 0.f;
#pragma unroll
                for (int rg = 0; rg < 4; ++rg) { float p[4];
#pragma unroll
                    for (int e = 0; e < 4; ++e) { const int sidx = 32 * st + 8 * rg + 4 * hh + e; const float sv = s0[4 * rg + e];
                        p[e] = (sidx <= t) ? sv * __expf(sa[sidx] - At) : 0.f; psum += p[e]; }
                    u32x2 o; o.x = cvt_pk_bf16(p[0], p[1]); o.y = cvt_pk_bf16(p[2], p[3]);
                    *(LAS u32x2*)(PL + t * PP + (32 * st + 8 * rg + 4 * hh) * 2) = o; }
                psum += __shfl_xor(psum, 32);
                if (hh == 0) atomicAdd((float*)(sdenp + t), psum);
            }
        }
        {
            const int mt = (wid & 1) + 2 * half, nt0 = wid >> 1;
            f32x16 acc[4];
#pragma unroll
            for (int i = 0; i < 4; ++i) acc[i] = zero16();
            float dq0 = 0.f;
            u32x4 btA[8], btB[8], rqA = (u32x4){0u, 0u, 0u, 0u}, rqB = rqA; f32x4 naA = (f32x4){0.f, 0.f, 0.f, 0.f}, nbA = naA, naB = naA, nbB = naA;
#define M4_LOAD(SL, BT_, RQ_, NA_, NB_) do { size_t zo_ = 0; asm volatile("" : "+v"(zo_)); const bf16_t* src_; \
                if ((SL) < 8) { const float* np8 = nstates + zo_ + (size_t)(c * 4 + head) * 512 + (SL) * 64 + 8 * cc; NA_ = *(const f32x4*)np8; NB_ = *(const f32x4*)(np8 + 4); \
                    RQ_ = *(const u32x4*)(qb + zo_ + (rbase + trow) * BIN + chh + (SL) * 64); \
                    src_ = states + zo_ + (((size_t)(c * 4 + head) * 512) + (SL) * 64 + rowp) * 512; } \
                else src_ = vb + zo_ + (rbase + ((SL) - 8) * 64 + rowp) * BIN + head * 512; \
                _Pragma("unroll") for (int i_ = 0; i_ < 8; ++i_) BT_[i_] = *(const u32x4*)(src_ + 8 * (cc + 8 * i_)); } while (0)
#define M4_ROUND(SL, BT_, RQ_, NA_, NB_) do { \
                BAR_LDS(); \
                if ((SL) < 8) { const float sc = ssc[trow]; float x[8]; unpack8(RQ_, x); \
                    _Pragma("unroll") for (int j = 0; j < 8; ++j) x[j] *= sc; \
                    dq0 += (x[0] * NA_[0] + x[1] * NA_[1]) + (x[2] * NA_[2] + x[3] * NA_[3]) + (x[4] * NB_[0] + x[5] * NB_[1]) + (x[6] * NB_[2] + x[7] * NB_[3]); \
                    u32x4 o; o.x = cvt_pk_bf16(x[0], x[1]); o.y = cvt_pk_bf16(x[2], x[3]); o.z = cvt_pk_bf16(x[4], x[5]); o.w = cvt_pk_bf16(x[6], x[7]); \
                    *(LAS u32x4*)(QS + rowp * KP + cc * 16) = o; } \
                _Pragma("unroll") for (int i = 0; i < 8; ++i) *(LAS u32x4*)(BT + rowp * BP + (cc + 8 * i) * 16) = BT_[i]; \
                if ((SL) + 2 < 10) M4_LOAD((SL) + 2, BT_, RQ_, NA_, NB_); \
                BAR_LDS(); \
                unsigned zl = 0; asm volatile("" : "+v"(zl) :: "memory"); \
                LAS const unsigned char* abase = (((SL) < 8) ? (QS + (32 * (wid & 1) + r32) * KP + 16 * hh) : (PL + (32 * mt + r32) * PP + (64 * ((SL) - 8) + 8 * hh) * 2)) + zl; \
                _Pragma("unroll") for (int ks = 0; ks < 4; ++ks) { \
                    const bf16x8 af = *(const LAS bf16x8*)(abase + 32 * ks); \
                    LAS const unsigned char* b0p = BT + zl + (16 * ks + 8 * hh + q4) * BP + tcol * 2; \
                    _Pragma("unroll") for (int i = 0; i < 4; ++i) { LAS const unsigned char* bp = b0p + (32 * (nt0 + 4 * i)) * 2; \
                        const bf16x8 bf = cat8(tr_read(bp), tr_read(bp + 4 * BP)); acc[i] = mfma32(af, bf, acc[i]); } } \
                asm volatile("" : "+v"(acc[0]), "+v"(acc[1]), "+v"(acc[2]), "+v"(acc[3]) :: "memory"); } while (0)
            M4_LOAD(0, btA, rqA, naA, nbA);
            M4_LOAD(1, btB, rqB, naB, nbB);
#pragma unroll 1
            for (int sl_ = 0; sl_ < 10; sl_ += 2) {
                int sl = sl_; asm volatile("" : "+s"(sl));
                M4_ROUND(sl, btA, rqA, naA, nbA);
                M4_ROUND(sl + 1, btB, rqB, naB, nbB);
            }
            dq0 += __shfl_xor(dq0, 1); dq0 += __shfl_xor(dq0, 2); dq0 += __shfl_xor(dq0, 4);
            if (cc == 0) sden[trow] = dq0;
            BAR_LDS();
#pragma unroll
            for (int r = 0; r < 16; ++r) { const int t = 32 * mt + (r & 3) + 8 * (r >> 2) + 4 * hh;
                const float dn = fmaxf(fabsf(sden[t] + sdenp[t]), __expf(-smt[t])); const float inv = __builtin_amdgcn_rcpf(dn); float q = 0.f;
#pragma unroll
                for (int i = 0; i < 4; ++i) { acc[i][r] *= inv; q += acc[i][r] * acc[i][r]; }
                q += __shfl_xor(q, 1); q += __shfl_xor(q, 2); q += __shfl_xor(q, 4); q += __shfl_xor(q, 8); q += __shfl_xor(q, 16);
                if (r32 == 0) sssq[nt0 * 128 + t] = q; }
            BAR_LDS();
#pragma unroll
            for (int i = 0; i < 4; ++i) { const int e = 32 * (nt0 + 4 * i) + r32; const int ch = head * 512 + e; const float hgv = hgain[ch], skv = skip[ch];
#pragma unroll
                for (int r = 0; r < 16; ++r) { const int t = 32 * mt + (r & 3) + 8 * (r >> 2) + 4 * hh;
                    const float rstd = rsqrtf(((sssq[t] + sssq[128 + t]) + (sssq[256 + t] + sssq[384 + t])) * (1.f / 512.f) + 1e-6f);
                    const size_t ro = (rbase + t) * BIN + ch;
                    const size_t rz = ((size_t)seg * SEG + rbase + t) * BIN + ch;
                    const float xcv = bf2f(xc[ro]), zv = bf2f(zg[rz]);
                    const float o = (acc[i][r] * rstd * hgv + skv * xcv) * (zv * __builtin_amdgcn_rcpf(1.f + __expf(-zv)));
                    zg[rz] = (bf16_t)(cvt_pk_bf16(o, 0.f) & 0xffffu); }
                asm volatile("" ::: "memory");
            }
        }
    }
}

#define XB_TMO      128
#define XB_XCNT(j)  (256  + 64 * (j))
#define XB_XSUB(j)  (1280 + 64 * (j))
#define XB_XGEN(j)  (2304 + 64 * (j))
#define XB_TOP      3328
#define XB_TOPGEN   3392
#define XCD_BAR_WORDS 3456
#define XB_SPIN_CAP (1u << 22)
__device__ __forceinline__ unsigned xb_ld(unsigned* p)              { return __hip_atomic_load(p, __ATOMIC_RELAXED, __HIP_MEMORY_SCOPE_AGENT); }
__device__ __forceinline__ unsigned xb_add(unsigned* p, unsigned v) { return __hip_atomic_fetch_add(p, v, __ATOMIC_RELAXED, __HIP_MEMORY_SCOPE_AGENT); }
__device__ __forceinline__ unsigned xb_xcc_id() { return (unsigned)__builtin_amdgcn_s_getreg((3 << 11) | 20) & 0xFu; }
#define XB_SPIN(cond, bar) do { unsigned _sp = 0; while (cond) { __builtin_amdgcn_s_sleep(1); \
    if ((++_sp & 255u) == 0u) { if (xb_ld(&(bar)[XB_TMO])) break; if (_sp > XB_SPIN_CAP) { atomicAdd(&(bar)[XB_TMO], 1u); break; } } } } while (0)
struct XcdBarrier { unsigned* bar; unsigned x; volatile LAS unsigned* st; };
__device__ __forceinline__ XcdBarrier xcd_barrier_post(unsigned* bar, volatile LAS unsigned* st) {
    XcdBarrier b; b.bar = bar; b.x = xb_xcc_id(); b.st = st;
    if (threadIdx.x == 0) (void)xb_add(&bar[XB_XCNT(b.x)], 1u);
    return b;
}
__device__ __forceinline__ void xcd_barrier_complete(unsigned* bar, unsigned x, unsigned& nloc, unsigned& nx) {
    const unsigned G = gridDim.x * gridDim.y * gridDim.z;
    unsigned sum, cnt, mine, sp = 0u;
    for (;;) {
        sum = 0u; cnt = 0u; mine = 0u;
#pragma unroll
        for (unsigned j = 0; j < 16; ++j) { const unsigned c = xb_ld(&bar[XB_XCNT(j)]); sum += c; cnt += (c > 0u) ? 1u : 0u; mine = (j == x) ? c : mine; }
        if (sum == G) break;
        __builtin_amdgcn_s_sleep(1);
        if ((++sp & 255u) == 0u) { if (xb_ld(&bar[XB_TMO])) break; if (sp > XB_SPIN_CAP) { atomicAdd(&bar[XB_TMO], 1u); break; } }
    }
    nloc = mine > 0u ? mine : 1u; nx = cnt > 0u ? cnt : 1u;
}
__device__ __forceinline__ void xcd_barrier(const XcdBarrier& b) {
    asm volatile("s_waitcnt vmcnt(0)" ::: "memory");
    __syncthreads();
    if (threadIdx.x == 0) {
        unsigned* bar = b.bar;
        __builtin_amdgcn_s_waitcnt(0);
        unsigned nloc = b.st[0], nx = b.st[1];
        if (nloc == 0u) { xcd_barrier_complete(bar, b.x, nloc, nx); b.st[0] = nloc; b.st[1] = nx; }
        const unsigned old = xb_add(&bar[XB_XSUB(b.x)], 1u);
        const unsigned gen = old / nloc;
        if (old + 1u == (gen + 1u) * nloc) {
            __builtin_amdgcn_fence(__ATOMIC_RELEASE, "agent");
            asm volatile("s_waitcnt vmcnt(0)" ::: "memory");
            const unsigned og = xb_add(&bar[XB_TOP], 1u);
            const unsigned tg = og / nx;
            if (og + 1u == (tg + 1u) * nx) xb_add(&bar[XB_TOPGEN], 1u);
            else XB_SPIN(xb_ld(&bar[XB_TOPGEN]) == tg, bar);
            __builtin_amdgcn_fence(__ATOMIC_ACQUIRE, "agent");
            xb_add(&bar[XB_XGEN(b.x)], 1u);
            asm volatile("s_waitcnt vmcnt(0)" ::: "memory");
        } else {
            XB_SPIN(xb_ld(&bar[XB_XGEN(b.x)]) == gen, bar);
            __builtin_amdgcn_fence(__ATOMIC_ACQUIRE, "agent");
            asm volatile("s_waitcnt vmcnt(0)" ::: "memory");
        }
    }
    __syncthreads();
}
constexpr size_t MS_BAR = 3 * ((size_t)1 << 20) + 65536;

__global__ void __launch_bounds__(512, 2) mega(Params P) {
    extern __shared__ __attribute__((aligned(16))) unsigned char lds_raw[];
    LAS unsigned char* lds = (LAS unsigned char*)lds_raw;
    cg::grid_group grid = cg::this_grid();
    const int G_ = gridDim.x, bx_ = blockIdx.x;
    unsigned char* ws_ = P.ws;
    float* xres_ = P.out;
    int ph = 0;
    XcdBarrier xbar; xbar.bar = nullptr; xbar.x = 0; xbar.st = nullptr;
    if (threadIdx.x < 2) ((volatile LAS unsigned*)(lds + 131072 + 64))[threadIdx.x] = 0u;
    __syncthreads();
#if !MULTI_LAUNCH
    xbar = xcd_barrier_post((unsigned*)(ws_ + WS_MISC + MS_BAR), (volatile LAS unsigned*)(lds + 131072 + 64));
#endif
#if MULTI_LAUNCH
#define OPAQUE unsigned char* ws = ws_; float* xres = xres_; int tid = threadIdx.x; int bx = bx_, G = G_; size_t zopq = 0; asm volatile("" : "+s"(zopq), "+v"(tid), "+s"(bx), "+s"(G)); ws += zopq; xres += zopq; float* misc = (float*)(ws + WS_MISC); \
    const int lane = tid & 63, wid = __builtin_amdgcn_readfirstlane(tid >> 6); const int gw = bx * 8 + wid, NGW = G * 8; const size_t gt = (size_t)bx * 512 + tid, ngt = (size_t)G * 512; \
    LAS float* scr = (LAS float*)(lds + wid * 16384); (void)misc; (void)xres; (void)lane; (void)gw; (void)NGW; (void)gt; (void)ngt; (void)scr;
#define PH_BEGIN if (ph >= P.ph_lo && ph < P.ph_hi) { OPAQUE
#define PH_END } ++ph;
#define PH_END_IF(c) } ++ph;
#else
#define OPAQUE unsigned char* ws = ws_; float* xres = xres_; int tid = threadIdx.x; int bx = bx_, G = G_; size_t zopq = 0; asm volatile("" : "+s"(zopq), "+v"(tid), "+s"(bx), "+s"(G)); ws += zopq; xres += zopq; float* misc = (float*)(ws + WS_MISC); \
    const int lane = tid & 63, wid = __builtin_amdgcn_readfirstlane(tid >> 6); const int gw = bx * 8 + wid, NGW = G * 8; const size_t gt = (size_t)bx * 512 + tid, ngt = (size_t)G * 512; \
    LAS float* scr = (LAS float*)(lds + wid * 16384); (void)misc; (void)xres; (void)lane; (void)gw; (void)NGW; (void)gt; (void)ngt; (void)scr;
#define PH_END_IF(c) if (c) xcd_barrier(xbar); } ++ph;
#define PH_BEGIN { OPAQUE
#define PH_END xcd_barrier(xbar); } ++ph;
#endif

    for (int layer = 0; layer < 2; ++layer) {
        const float* w1 = as_global(P.in[I_MW1]) + (size_t)layer * DM * DFF; const float* w2 = as_global(P.in[I_MW2]) + (size_t)layer * DFF * DM;
        const float* wg = as_global(P.in[I_PWG]) + (size_t)layer * DM * DM; const float* wp = as_global(P.in[I_PWP]) + (size_t)layer * PLE * DM;
        const float* pin = as_global(P.in[I_P]) + (size_t)layer * S * PLE;
        if (layer == 0) {
            PH_BEGIN
                convert_mat(as_global(P.in[I_AWQKV]), DM, 9216, (bf16_t*)(ws + W_QKV), scr, gw, NGW, lane);
                convert_mat(as_global(P.in[I_AWO]), DM, DM, (bf16_t*)(ws + W_O), scr, gw, NGW, lane);
                convert_mat(w1, DM, DFF, (bf16_t*)(ws + W_1), scr, gw, NGW, lane);
                convert_mat(w2, DFF, DM, (bf16_t*)(ws + W_2), scr, gw, NGW, lane);
                convert_mat(wg, DM, DM, (bf16_t*)(ws + W_G), scr, gw, NGW, lane);
                convert_mat(wp, PLE, DM, (bf16_t*)(ws + W_P), scr, gw, NGW, lane);
                convert_flat(pin, (bf16_t*)(ws + WS_PB), (size_t)S * PLE / 8, gt, ngt);
                if (bx == 0 && wid == 0) { float mq = 0.f, mk = 0.f;
                    for (int i = lane; i < 192; i += 64) { mq = fmaxf(mq, fabsf(as_global(P.in[I_AQG])[i])); mk = fmaxf(mk, fabsf(as_global(P.in[I_AKG])[i])); }
                    mq = wave_max(mq); mk = wave_max(mk); if (lane == 0) misc[0] = 8.f * mq * mk * LOG2E * 1.02f; }
                norm_rows_d<4>(as_global(P.in[I_X]), as_global(P.in[I_ANORM]), (bf16_t*)(ws + WS_H), S, gw, NGW, lane);
            PH_END
            for (int g = 0; g < 3; ++g) {
                PH_BEGIN
                    pg8::Gemm gm{(const bf16_t*)(ws + WS_H), (const bf16_t*)(ws + W_QKV) + (size_t)g * 3072 * DM, S, 3072, DM};
                    pg8::StaticOrder so; so.init(S, 3072, G, bx);
                    EpiBf16<0> E{(bf16_t*)(ws + WS_QKV), 3072, 2 * g, S, 0, nullptr, 0};
                    pg8::gemm_phase<EpiBf16<0>, pg8::StaticOrder>(lds, tid, gm, so, E);
                PH_END
                PH_BEGIN
                    attn_phase(lds, tid, (const bf16_t*)(ws + WS_QKV), g, (float*)(ws + WS_NACC), (float*)(ws + WS_Z), (bf16_t*)(ws + WS_H), as_global(P.in[I_AQG]), as_global(P.in[I_AKG]), misc[0]);
                PH_END
            }
            PH_BEGIN
                pg8::Gemm gm{(const bf16_t*)(ws + WS_H), (const bf16_t*)(ws + W_O), S, DM, DM};
                pg8::StaticOrder so; so.init(S, DM, G, bx);
                EpiF32<1> E{xres, as_global(P.in[I_X]), nullptr, DM};
                pg8::gemm_phase<EpiF32<1>, pg8::StaticOrder>(lds, tid, gm, so, E);
            PH_END
        } else {
            PH_BEGIN
                convert_mat_np(as_global(P.in[I_BWUP]), DM, 2 * BIN, (bf16_t*)(ws + W_UP), scr, gw, NGW, lane);
                convert_mat_np(as_global(P.in[I_BWDOWN]), BIN, DM, (bf16_t*)(ws + W_DOWN), scr, gw, NGW, lane);
                if (bx == 0) { for (int i = tid; i < 3 * BIN / 8; i += 512) ((u32x4*)(ws + WS_XM))[i] = (u32x4){0u, 0u, 0u, 0u}; }
                if (bx == 1 % G) m2_fold(tid, as_global(P.in[I_BWQ]), as_global(P.in[I_BWK]), as_global(P.in[I_BWV]), as_global(P.in[I_BWG]), misc + MS_GFOLD / 4);
                norm_rows(xres, as_global(P.in[I_BNORM]), (bf16_t*)(ws + WS_HSEG), SEG, gw, NGW, lane);
            PH_END
            PH_BEGIN
                pg8::Gemm gm{(const bf16_t*)(ws + WS_HSEG), (const bf16_t*)(ws + W_UP), SEG, 2 * BIN, DM};
                pg8::StaticOrder so; so.init(SEG, 2 * BIN, G, bx);
                EpiBf16<0> E{(bf16_t*)(ws + WS_XM) + 3 * BIN, BIN, 0, SEG, 8, (bf16_t*)(ws + WS_ZG), 0};
                pg8::gemm_phase<EpiBf16<0>, pg8::StaticOrder>(lds, tid, gm, so, E);
            PH_END
            for (int seg = 0; seg < NSEG; ++seg) {
                PH_BEGIN
                    m2_phase(lds, tid, bx, G, seg, (const bf16_t*)(ws + WS_XM), (bf16_t*)(ws + WS_XC), (bf16_t*)(ws + WS_QB), (bf16_t*)(ws + WS_KB), (bf16_t*)(ws + WS_VB), misc + MS_IPRE / 4, misc + MS_LOGF / 4,
                             as_global(P.in[I_BCW]), as_global(P.in[I_BCB]), as_global(P.in[I_BWQ]), as_global(P.in[I_BWK]), as_global(P.in[I_BWV]), misc + MS_GFOLD / 4, as_global(P.in[I_BBG]));
                PH_END
                PH_BEGIN
                    if (seg + 1 < NSEG) norm_rows(xres + (size_t)(seg + 1) * SEG * DM, as_global(P.in[I_BNORM]), (bf16_t*)(ws + WS_HSEG), SEG, gw, NGW, lane);
                    m3_phase(lds, tid, bx, G, seg, (const bf16_t*)(ws + WS_KB), (const bf16_t*)(ws + WS_VB), misc + MS_IPRE / 4, misc + MS_LOGF / 4,
                             (bf16_t*)(ws + WS_ST), misc + MS_NST / 4, misc + MS_MPREV / 4, misc + MS_MCARRY / 4, (float*)(ws + WS_CARRY), misc + MS_NCARRY / 4);
                    if (seg + 1 < NSEG && bx == G - 1) { for (int i = tid; i < 3 * BIN / 8; i += 512) ((u32x4*)(ws + WS_XM))[i] = ((const u32x4*)(ws + WS_XM + (size_t)SEG * BIN * 2))[i]; }
                PH_END
                PH_BEGIN
                    m4_phase(lds, tid, bx, G, seg, (const bf16_t*)(ws + WS_QB), (const bf16_t*)(ws + WS_KB), (const bf16_t*)(ws + WS_VB), (const bf16_t*)(ws + WS_XC), (bf16_t*)(ws + WS_ZG), misc + MS_IPRE / 4, misc + MS_LOGF / 4,
                             (const bf16_t*)(ws + WS_ST), misc + MS_NST / 4, misc + MS_MPREV / 4, as_global(P.in[I_BHG]), as_global(P.in[I_BSKIP]));
                    if (seg + 1 < NSEG) {
                        __syncthreads();
                        pg8::Gemm gm{(const bf16_t*)(ws + WS_HSEG), (const bf16_t*)(ws + W_UP), SEG, 2 * BIN, DM};
                        pg8::StaticOrder so; so.init(SEG, 2 * BIN, G, bx);
                        EpiBf16<0> E{(bf16_t*)(ws + WS_XM) + 3 * BIN, BIN, 0, SEG, 8, (bf16_t*)(ws + WS_ZG) + (size_t)(seg + 1) * SEG * BIN, 0};
                        pg8::gemm_phase<EpiBf16<0>, pg8::StaticOrder>(lds, tid, gm, so, E);
                    }
                PH_END
            }
            PH_BEGIN
                pg8::Gemm gm{(const bf16_t*)(ws + WS_ZG), (const bf16_t*)(ws + W_DOWN), S, DM, BIN};
                pg8::StaticOrder so; so.init(S, DM, G, bx);
                EpiF32<1> E{xres, xres, nullptr, DM};
                pg8::gemm_phase<EpiF32<1>, pg8::StaticOrder>(lds, tid, gm, so, E);
            PH_END
        }
        PH_BEGIN
            if (layer == 1) {
                convert_mat_np(w1, DM, DFF, (bf16_t*)(ws + W_1), scr, gw, NGW, lane);
                convert_mat_np(w2, DFF, DM, (bf16_t*)(ws + W_2), scr, gw, NGW, lane);
                convert_mat_np(wg, DM, DM, (bf16_t*)(ws + W_G), scr, gw, NGW, lane);
                convert_mat_np(wp, PLE, DM, (bf16_t*)(ws + W_P), scr, gw, NGW, lane);
                convert_flat(pin, (bf16_t*)(ws + WS_PB), (size_t)S * PLE / 8, gt, ngt);
            }
            norm_rows_d<4>(xres, as_global(P.in[I_MNORM]) + layer * DM, (bf16_t*)(ws + WS_H), S, gw, NGW, lane);
        PH_END
        PH_BEGIN
            pg8::Gemm gm{(const bf16_t*)(ws + WS_H), (const bf16_t*)(ws + W_1), S, DFF, DM};
            pg8::StaticOrder so; so.init(S, DFF, G, bx);
            EpiBf16<1> E{(bf16_t*)(ws + WS_HID), DFF, 0, S, 0, nullptr, 0};
            pg8::gemm_phase<EpiBf16<1>, pg8::StaticOrder>(lds, tid, gm, so, E);
        PH_END
        PH_BEGIN
            pg8::Gemm gm{(const bf16_t*)(ws + WS_HID), (const bf16_t*)(ws + W_2), S, DM, DFF};
            pg8::StaticOrder so; so.init(S, DM, G, bx);
            EpiF32<1> E{xres, xres, nullptr, DM};
            pg8::gemm_phase<EpiF32<1>, pg8::StaticOrder>(lds, tid, gm, so, E);
        PH_END
        PH_BEGIN
            norm_rows_d<4>(xres, as_global(P.in[I_PNORM]) + layer * DM, (bf16_t*)(ws + WS_H), S, gw, NGW, lane);
        PH_END
        PH_BEGIN
            {   pg8::Gemm gm{(const bf16_t*)(ws + WS_PB), (const bf16_t*)(ws + W_P), S, DM, PLE};
                pg8::StaticOrder so; so.init(S, DM, G, bx);
                EpiBf16<0> E{(bf16_t*)(ws + WS_PE), DM, 0, S, 0, nullptr, 0};
                pg8::gemm_phase<EpiBf16<0>, pg8::StaticOrder>(lds, tid, gm, so, E); }
            {   pg8::Gemm gm{(const bf16_t*)(ws + WS_H), (const bf16_t*)(ws + W_G), S, DM, DM};
                pg8::StaticOrder so; so.init(S, DM, G, bx);
                EpiF32<2> E{xres, xres, (const float*)(ws + WS_PE), DM};
                pg8::gemm_phase<EpiF32<2>, pg8::StaticOrder>(lds, tid, gm, so, E); }
        PH_END_IF(layer == 0)
    }
}

constexpr int NPHASES = 1 + 6 + 1 + 5 + 15 + 5;

extern "C" void kernel_launch(void* const* d_in, const int* in_sizes, int n_in, void* d_out, int out_size, void* d_ws, size_t ws_size, hipStream_t stream) {
    static int grid = 0;
    if (grid == 0) {
        if (n_in != 25 || ws_size < WS_END) { fprintf(stderr, "kernel_launch: unexpected n_in %d / ws %zu\n", n_in, ws_size); grid = -1; return; }
        int dev = 0, cus = 0, per_cu = 0;
        hipGetDevice(&dev); hipDeviceGetAttribute(&cus, hipDeviceAttributeMultiprocessorCount, dev);
        hipFuncSetAttribute((const void*)mega, hipFuncAttributeMaxDynamicSharedMemorySize, LDS_BYTES);
        hipOccupancyMaxActiveBlocksPerMultiprocessor(&per_cu, (const void*)mega, 512, LDS_BYTES);
        if (per_cu < 1) { fprintf(stderr, "kernel_launch: occupancy query says %d blocks/CU\n", per_cu); per_cu = 1; }
        (void)hipGetLastError();
        grid = cus * 1;
    }
    if (grid < 0) return;
    Params p{};
    for (int i = 0; i < 25; ++i) p.in[i] = (const float*)d_in[i];
    p.out = (float*)d_out; p.ws = (unsigned char*)d_ws;
#if MULTI_LAUNCH
    for (int ph = 0; ph < NPHASES; ++ph) { p.ph_lo = ph; p.ph_hi = ph + 1; hipLaunchKernelGGL(mega, dim3(grid), dim3(512), LDS_BYTES, stream, p); }
#else
    p.ph_lo = 0; p.ph_hi = NPHASES;
    if (hipMemsetAsync((unsigned char*)d_ws + WS_MISC + MS_BAR, 0, XCD_BAR_WORDS * 4, stream) != hipSuccess) { fprintf(stderr, "kernel_launch: memset of the barrier words failed\n"); return; }
    void* args[] = {&p};
    hipError_t e = hipLaunchCooperativeKernel((const void*)mega, dim3(grid), dim3(512), args, LDS_BYTES, stream);
    if (e != hipSuccess) fprintf(stderr, "cooperative launch failed: %s (grid %d)\n", hipGetErrorString(e), grid);
#endif
}
```

```cpp
#include <hip/hip_runtime.h>
#include <hip/hip_cooperative_groups.h>
#include <cstdio>
namespace cg = cooperative_groups;

#ifndef MULTI_LAUNCH
#define MULTI_LAUNCH 0
#endif

#define LAS __attribute__((address_space(3)))
typedef unsigned short bf16_t;
typedef short bf16x8 __attribute__((ext_vector_type(8)));
typedef short s16x4 __attribute__((ext_vector_type(4)));
typedef float f32x4 __attribute__((ext_vector_type(4)));
typedef float f32x2 __attribute__((ext_vector_type(2)));
typedef float f32x16 __attribute__((ext_vector_type(16)));
typedef unsigned u32x4 __attribute__((ext_vector_type(4)));
typedef unsigned u32x2 __attribute__((ext_vector_type(2)));

#define GAS __attribute__((address_space(1)))
template <class T> __device__ __forceinline__ T* as_global(T* p) { return p; }
#define LDS_WAIT() asm volatile("s_waitcnt lgkmcnt(0)" ::: "memory")
#define BAR_LDS() do { asm volatile("s_waitcnt lgkmcnt(0)" ::: "memory"); __builtin_amdgcn_s_barrier(); asm volatile("" ::: "memory"); } while (0)

__device__ __forceinline__ unsigned cvt_pk_bf16(float lo, float hi) { unsigned r; asm("v_cvt_pk_bf16_f32 %0, %1, %2" : "=v"(r) : "v"(lo), "v"(hi)); return r; }
__device__ __forceinline__ float bf2f(unsigned short b) { return __uint_as_float(((unsigned)b) << 16); }
__device__ __forceinline__ float bflo(unsigned u) { return __uint_as_float(u << 16); }
__device__ __forceinline__ float bfhi(unsigned u) { return __uint_as_float(u & 0xffff0000u); }
__device__ __forceinline__ float wave_sum(float v) {
#pragma unroll
    for (int o = 1; o < 64; o <<= 1) v += __shfl_xor(v, o);
    return v;
}
__device__ __forceinline__ float wave_max(float v) {
#pragma unroll
    for (int o = 1; o < 64; o <<= 1) v = fmaxf(v, __shfl_xor(v, o));
    return v;
}
__device__ __forceinline__ f32x16 mfma32(bf16x8 a, bf16x8 b, f32x16 c) { return __builtin_amdgcn_mfma_f32_32x32x16_bf16(a, b, c, 0, 0, 0); }
typedef short v4i16_t __attribute__((ext_vector_type(4)));
__device__ __forceinline__ s16x4 tr_read(LAS const unsigned char* p) { return __builtin_bit_cast(s16x4, __builtin_amdgcn_ds_read_tr16_b64_v4i16((LAS v4i16_t*)p)); }
__device__ __forceinline__ bf16x8 cat8(s16x4 a, s16x4 b) { return (bf16x8){a[0], a[1], a[2], a[3], b[0], b[1], b[2], b[3]}; }
__device__ __forceinline__ f32x16 zero16() { f32x16 z;
#pragma unroll
    for (int i = 0; i < 16; ++i) z[i] = 0.f; return z; }

namespace pg8 {
constexpr int BM = 256, BK = 64, HALF = 128, HTB = HALF * BK * 2, STAGE_BYTES = 8 * HTB, NXCD = 8, WGM = 8;
__host__ __device__ __forceinline__ int lds_byte(int r, int c) { const int st = (r >> 4) * 2 + (c >> 5), rr = r & 15, cc = c & 31, ob = rr * 64 + cc * 2; return st * 1024 + (ob ^ (((ob >> 9) & 1) << 5)); }
__host__ __device__ __forceinline__ void stage_rc(int b, int& R, int& C) { const int st = b / 1024, sb = b % 1024, swz = sb ^ (((sb >> 9) & 1) << 5); R = (st >> 1) * 16 + swz / 64; C = (st & 1) * 32 + (swz % 64) / 2; }
__host__ __device__ __forceinline__ int perm32(int rho) { const int n = rho >> 4, i = rho & 15; return 8 * (i >> 2) + 4 * n + (i & 3); }
struct Unit { int pm, pn; };
struct Gemm { const bf16_t* A; const bf16_t* Bt; int M, N, K; };
struct StaticOrder {
    int nM, nN, nwg, G, c;
    __host__ __device__ void init(int M, int N, int G_, int c_) { nM = M / BM; nN = N / BM; nwg = nM * nN; G = G_; c = c_; }
    __host__ __device__ bool next(int i, Unit& u) const {
        const long L = (long)i * G + c; if (L >= nwg) return false;
        int wgid = (int)L; { const int q = nwg / NXCD, r = nwg % NXCD, xcd = wgid % NXCD, off = wgid / NXCD; wgid = (xcd < r ? xcd * (q + 1) : r * (q + 1) + (xcd - r) * q) + off; }
        const int nig = WGM * nN, gid = wgid / nig, fm = gid * WGM, gsz = (nM - fm) < WGM ? (nM - fm) : WGM;
        u.pm = fm + ((wgid % nig) % gsz); u.pn = (wgid % nig) / gsz; return true;
    }
    __device__ __forceinline__ void a_ready(const Unit&) const {}
    __device__ __forceinline__ void done(const Unit&) const {}
};

template <class Epi, class Sched>
__device__ __forceinline__ void gemm_phase(LAS unsigned char* lds, const int tid, const Gemm g, const Sched& S, const Epi& E) {
    const int wid = __builtin_amdgcn_readfirstlane(tid >> 6), lane = tid & 63, wr = wid >> 2, wc = wid & 3, fr = lane & 15, fq = lane >> 4;
    const int K = g.K, nt = K / BK;
    unsigned voffA[2], voffB[2];
#pragma unroll
    for (int i = 0; i < 2; ++i) { int R, C; stage_rc(tid * 16 + i * 8192, R, C); const int Rb = Epi::PERM ? ((R & ~31) + perm32(R & 31)) : R;
        voffA[i] = (unsigned)(R * K + C) * 2u; voffB[i] = (unsigned)(Rb * K + C) * 2u; }
    const size_t kstep = (size_t)(BK * 2);
    const size_t hstep = (size_t)HALF * K * 2;
    const size_t tstep = 2 * hstep;
    const unsigned ldsw = (unsigned)wid * 1024u;
    const int aoff = lds_byte(wr * 64 + fr, fq * 8), boff = lds_byte(wc * 32 + fr, fq * 8);
#define PG8_SA(b, h) (((b) * 2 + (h)) * HTB)
#define PG8_SB(b, h) ((4 + (b) * 2 + (h)) * HTB)
#define PG8_STAGE(bufoff, gbase, voff) do { _Pragma("unroll") for (int _i = 0; _i < 2; ++_i) \
        __builtin_amdgcn_global_load_lds((const unsigned*)((const char*)(gbase) + (voff)[_i]), (LAS unsigned*)(lds + (bufoff) + ldsw + _i * 8192), 16, 0, 0); } while (0)
#define PG8_LDA(dst, b, h) do { _Pragma("unroll") for (int m = 0; m < 4; ++m) _Pragma("unroll") for (int k = 0; k < 2; ++k) dst[m][k] = *(const LAS bf16x8*)(lds + PG8_SA(b, h) + aoff + m * 2048 + k * 1024); } while (0)
#define PG8_LDB(dst, b, h) do { _Pragma("unroll") for (int n = 0; n < 2; ++n) _Pragma("unroll") for (int k = 0; k < 2; ++k) dst[n][k] = *(const LAS bf16x8*)(lds + PG8_SB(b, h) + boff + n * 2048 + k * 1024); } while (0)
#define PG8_MMA(ai, bj, At, Bt) do { __builtin_amdgcn_s_setprio(1); _Pragma("unroll") for (int m = 0; m < 4; ++m) _Pragma("unroll") for (int n = 0; n < 2; ++n) _Pragma("unroll") for (int k = 0; k < 2; ++k) \
        acc[ai][bj][m][n] = __builtin_amdgcn_mfma_f32_16x16x32_bf16(Bt[n][k], At[m][k], acc[ai][bj][m][n], 0, 0, 0); __builtin_amdgcn_s_setprio(0); } while (0)
#define PG8_WAIT_V(n) asm volatile("s_waitcnt vmcnt(" #n ")" ::: "memory")
#define PG8_WAIT_L(n) asm volatile("s_waitcnt lgkmcnt(" #n ")" ::: "memory")
#define PG8_BAR __builtin_amdgcn_s_barrier()
#define PG8_SCHED __builtin_amdgcn_sched_barrier(0)
    Unit cur, nxt; int ui = 0;
    if (!S.next(0, cur)) return;
    f32x4 acc[2][2][4][2];
#pragma unroll
    for (int a = 0; a < 2; ++a)
#pragma unroll
        for (int b = 0; b < 2; ++b)
#pragma unroll
            for (int m = 0; m < 4; ++m)
#pragma unroll
                for (int n = 0; n < 2; ++n) acc[a][b][m][n] = (f32x4){0.f, 0.f, 0.f, 0.f};
    bf16x8 At[4][2], B0[2][2], B1[2][2];
    const char* cA = (const char*)g.A + (size_t)cur.pm * tstep; const char* cB = (const char*)g.Bt + (size_t)cur.pn * tstep;
    S.a_ready(cur);
    PG8_STAGE(PG8_SB(0, 0), cB, voffB); PG8_STAGE(PG8_SA(0, 0), cA, voffA); PG8_STAGE(PG8_SB(0, 1), cB + hstep, voffB); PG8_STAGE(PG8_SA(0, 1), cA + hstep, voffA);
    if (wr == 1) PG8_BAR;
    PG8_WAIT_V(4); PG8_BAR;
    PG8_STAGE(PG8_SB(1, 0), cB + kstep, voffB); PG8_STAGE(PG8_SA(1, 0), cA + kstep, voffA); PG8_STAGE(PG8_SB(1, 1), cB + hstep + kstep, voffB);
    PG8_WAIT_V(6); PG8_BAR;
    for (;;) {
        const bool has_next = S.next(ui + 1, nxt);
        const char* nA = has_next ? (const char*)g.A + (size_t)nxt.pm * tstep : cA; const char* nB = has_next ? (const char*)g.Bt + (size_t)nxt.pn * tstep : cB;
        for (int t = 0; t < nt; t += 2) {
            const bool last = (t == nt - 2);
            const char* a1 = cA + (size_t)(t + 1) * kstep;
            const char* a2 = last ? nA : cA + (size_t)(t + 2) * kstep; const char* b2 = last ? nB : cB + (size_t)(t + 2) * kstep;
            const char* a3 = a2 + kstep; const char* b3 = b2 + kstep;
            if (last && has_next) S.a_ready(nxt);
            PG8_LDB(B0, 0, 0); PG8_SCHED; PG8_LDA(At, 0, 0); PG8_STAGE(PG8_SA(1, 1), a1 + hstep, voffA);
            PG8_WAIT_L(8); PG8_BAR; PG8_WAIT_L(0); PG8_MMA(0, 0, At, B0); PG8_BAR; PG8_SCHED;
            PG8_LDB(B1, 0, 1); PG8_STAGE(PG8_SB(0, 0), b2, voffB);
            PG8_BAR; PG8_WAIT_L(0); PG8_MMA(0, 1, At, B1); PG8_BAR;
            PG8_LDA(At, 0, 1); PG8_STAGE(PG8_SA(0, 0), a2, voffA);
            PG8_BAR; PG8_WAIT_L(0); PG8_MMA(1, 0, At, B0); PG8_BAR; PG8_SCHED;
            PG8_STAGE(PG8_SB(0, 1), b2 + hstep, voffB);
            PG8_WAIT_V(6); PG8_BAR; PG8_MMA(1, 1, At, B1); PG8_BAR;
            PG8_LDB(B0, 1, 0); PG8_SCHED; PG8_LDA(At, 1, 0); PG8_STAGE(PG8_SA(0, 1), a2 + hstep, voffA);
            PG8_WAIT_L(8); PG8_BAR; PG8_WAIT_L(0); PG8_MMA(0, 0, At, B0); PG8_BAR; PG8_SCHED;
            PG8_LDB(B1, 1, 1); PG8_STAGE(PG8_SB(1, 0), b3, voffB);
            PG8_BAR; PG8_WAIT_L(0); PG8_MMA(0, 1, At, B1); PG8_BAR;
            PG8_LDA(At, 1, 1); PG8_STAGE(PG8_SA(1, 0), a3, voffA);
            PG8_BAR; PG8_WAIT_L(0); PG8_MMA(1, 0, At, B0); PG8_BAR; PG8_SCHED;
            PG8_STAGE(PG8_SB(1, 1), b3 + hstep, voffB);
            PG8_WAIT_V(6); PG8_BAR; PG8_MMA(1, 1, At, B1); PG8_BAR;
        }
        E(acc, cur, wr, wc, fr, fq); S.done(cur);
        if (!has_next) break;
#pragma unroll
        for (int a = 0; a < 2; ++a)
#pragma unroll
            for (int b = 0; b < 2; ++b)
#pragma unroll
                for (int m = 0; m < 4; ++m)
#pragma unroll
                    for (int n = 0; n < 2; ++n) acc[a][b][m][n] = (f32x4){0.f, 0.f, 0.f, 0.f};
        cur = nxt; cA = nA; cB = nB; ++ui;
    }
    PG8_WAIT_V(0);
    if (wr == 0) PG8_BAR;
    PG8_BAR;
#undef PG8_SA
#undef PG8_SB
#undef PG8_STAGE
#undef PG8_LDA
#undef PG8_LDB
#undef PG8_MMA
#undef PG8_WAIT_V
#undef PG8_WAIT_L
#undef PG8_BAR
#undef PG8_SCHED
}
}

typedef f32x4 AccT[2][2][4][2];

template <int ACT> struct EpiBf16 {
    static constexpr bool PERM = true;
    bf16_t* O; int ldc; int dsh; int Ltot;
    int split_tile; bf16_t* O2; size_t rowoff2;
    __device__ __forceinline__ void operator()(const AccT& acc, const pg8::Unit& u, int wr, int wc, int fr, int fq) const {
        const int row0 = u.pm * 256 + wr * 64 + fr; int colt = u.pn * 256; bf16_t* base = O;
        if (split_tile && u.pn >= split_tile) { base = O2; colt -= split_tile * 256; }
        const int col0 = colt + wc * 32 + 8 * fq;
        const int dm = (1 << dsh) - 1, L = Ltot >> dsh;
#pragma unroll
        for (int ai = 0; ai < 2; ++ai)
#pragma unroll
            for (int m = 0; m < 4; ++m) {
                const int r = row0 + ai * 128 + m * 16; const int dr = (r & dm) * L + (r >> dsh);
                bf16_t* rowp = base + (size_t)dr * ldc + col0;
#pragma unroll
                for (int bj = 0; bj < 2; ++bj) { f32x4 v0 = acc[ai][bj][m][0], v1 = acc[ai][bj][m][1];
                    if (ACT == 1) {
#pragma unroll
                        for (int e = 0; e < 4; ++e) { float a = fmaxf(v0[e], 0.f); v0[e] = a * a; float b = fmaxf(v1[e], 0.f); v1[e] = b * b; } }
                    u32x4 o; o.x = cvt_pk_bf16(v0[0], v0[1]); o.y = cvt_pk_bf16(v0[2], v0[3]); o.z = cvt_pk_bf16(v1[0], v1[1]); o.w = cvt_pk_bf16(v1[2], v1[3]);
                    *(u32x4*)(rowp + bj * 128) = o; }
            }
    }
};
template <int MODE> struct EpiF32 {
    static constexpr bool PERM = false;
    static constexpr int DEPTH = (MODE == 2) ? 2 : 3;
    float* C; const float* R; const float* PE; int ldc;
    __device__ __forceinline__ void operator()(const AccT& acc, const pg8::Unit& u, int wr, int wc, int fr, int fq) const {
        const int row0 = u.pm * 256 + wr * 64 + fr, col0 = u.pn * 256 + wc * 32 + 4 * fq;
        f32x4 rn[DEPTH][4]; u32x2 pn_[DEPTH][4];
        if (MODE != 0) {
#pragma unroll
            for (int d = 0; d < DEPTH; ++d) { const size_t ro = (size_t)(row0 + (d >> 2) * 128 + (d & 3) * 16) * ldc + col0;
#pragma unroll
                for (int q = 0; q < 4; ++q) { const size_t o = ro + (q >> 1) * 128 + (q & 1) * 16; rn[d][q] = *(const f32x4*)(R + o); if (MODE == 2) pn_[d][q] = *(const u32x2*)((const bf16_t*)PE + o); } }
        }
#pragma unroll
        for (int g8 = 0; g8 < 8; ++g8) { const int ai = g8 >> 2, m = g8 & 3, sl = g8 % DEPTH;
            const size_t ro = (size_t)(row0 + ai * 128 + m * 16) * ldc + col0;
            f32x4 rc[4]; u32x2 pc[4];
#pragma unroll
            for (int q = 0; q < 4; ++q) { rc[q] = rn[sl][q]; pc[q] = pn_[sl][q]; }
            if (MODE != 0 && g8 + DEPTH < 8) { const int ai2 = (g8 + DEPTH) >> 2, m2 = (g8 + DEPTH) & 3; const size_t ro2 = (size_t)(row0 + ai2 * 128 + m2 * 16) * ldc + col0;
#pragma unroll
                for (int q = 0; q < 4; ++q) { const size_t o = ro2 + (q >> 1) * 128 + (q & 1) * 16; rn[sl][q] = *(const f32x4*)(R + o); if (MODE == 2) pn_[sl][q] = *(const u32x2*)((const bf16_t*)PE + o); } }
#pragma unroll
            for (int q = 0; q < 4; ++q) { const int bj = q >> 1, n = q & 1; const size_t o = ro + bj * 128 + n * 16; f32x4 v = acc[ai][bj][m][n];
                if (MODE == 1) { v = v + rc[q]; }
                if (MODE == 2) { f32x4 pe; pe[0] = bflo(pc[q].x); pe[1] = bfhi(pc[q].x); pe[2] = bflo(pc[q].y); pe[3] = bfhi(pc[q].y);
#pragma unroll
                    for (int e = 0; e < 4; ++e) v[e] = rc[q][e] + pe[e] * __builtin_amdgcn_rcpf(1.f + __expf(-v[e])); }
                *(f32x4*)(C + o) = v; }
        }
    }
};

constexpr int S = 16384, DM = 1024, DFF = 4096, PLE = 256, BIN = 2048;
constexpr size_t MiB = (size_t)1 << 20;
constexpr size_t WS_MISC = 0;
constexpr size_t WS_W = 4 * MiB;
constexpr size_t W_QKV = WS_W, W_UP = WS_W, W_O = WS_W + 18 * MiB, W_DOWN = WS_W + 18 * MiB, W_1 = WS_W + 22 * MiB, W_2 = WS_W + 30 * MiB, W_G = WS_W + 38 * MiB, W_P = WS_W + 40 * MiB;
constexpr size_t WS_PB = 45 * MiB;
constexpr size_t WS_H = 60 * MiB;
constexpr size_t WS_QKV = 92 * MiB;
constexpr size_t WS_NACC = 188 * MiB;
constexpr size_t WS_Z = 252 * MiB;
constexpr size_t WS_HID = 92 * MiB;
constexpr size_t WS_PE = 92 * MiB;
constexpr size_t WS_END = 256 * MiB;
constexpr int LDS_BYTES = 147456;
constexpr float LOG2E = 1.4426950408889634f;

struct Params { const float* in[25]; float* out; unsigned char* ws; int ph_lo, ph_hi; };
enum { I_X = 0, I_P, I_ANORM, I_AWQKV, I_AQG, I_AKG, I_AWO, I_BNORM, I_BWUP, I_BCW, I_BCB, I_BWQ, I_BWK, I_BWV, I_BWG, I_BBG, I_BHG, I_BSKIP, I_BWDOWN, I_MNORM, I_MW1, I_MW2, I_PNORM, I_PWG, I_PWP };

__device__ __forceinline__ void ti_load(const float* W, int N, int item, int lane, float* r) {
    const int nblk = N / 32, kb = item / nblk, nb = item % nblk, k0 = 64 * kb, n0 = 32 * nb;
#pragma unroll
    for (int i = 0; i < 32; ++i) { const int kk = 2 * i + (lane >> 5); r[i] = W[(size_t)(k0 + kk) * N + n0 + (lane & 31)]; }
}
__device__ __forceinline__ void ti_put(const float* r, LAS float* scr, int lane) {
#pragma unroll
    for (int i = 0; i < 32; ++i) { const int kk = 2 * i + (lane >> 5); scr[kk * 33 + (lane & 31)] = r[i]; }
    LDS_WAIT();
}
__device__ __forceinline__ void ti_out(int K, int N, bf16_t* WT, LAS float* scr, int item, int lane) {
    const int nblk = N / 32, kb = item / nblk, nb = item % nblk, k0 = 64 * kb, n0 = 32 * nb;
    const int c = lane & 7;
#pragma unroll
    for (int j = 0; j < 4; ++j) { const int n = (lane >> 3) + 8 * j; const LAS float* s = scr + (8 * c) * 33 + n;
        u32x4 o; o.x = cvt_pk_bf16(s[0 * 33], s[1 * 33]); o.y = cvt_pk_bf16(s[2 * 33], s[3 * 33]); o.z = cvt_pk_bf16(s[4 * 33], s[5 * 33]); o.w = cvt_pk_bf16(s[6 * 33], s[7 * 33]);
        *(u32x4*)(WT + (size_t)(n0 + n) * K + k0 + 8 * c) = o; }
    LDS_WAIT();
}
__device__ __forceinline__ void convert_mat(const float* W, int K, int N, bf16_t* WT, LAS float* scr, int gw, int NGW, int lane) {
    const int nitems = (K / 64) * (N / 32);
    float r[32];
    if (gw < nitems) ti_load(W, N, gw, lane, r);
    for (int it = gw; it < nitems; it += NGW) {
        ti_put(r, scr, lane);
        if (it + NGW < nitems) ti_load(W, N, it + NGW, lane, r);
        ti_out(K, N, WT, scr, it, lane);
    }
}
__device__ __forceinline__ void convert_mat_np(const float* W, int K, int N, bf16_t* WT, LAS float* scr, int gw, int NGW, int lane) {
    const int nitems = (K / 64) * (N / 32);
    for (int it = gw; it < nitems; it += NGW) { float r[32]; ti_load(W, N, it, lane, r); ti_put(r, scr, lane); ti_out(K, N, WT, scr, it, lane); }
}
__device__ __forceinline__ void convert_flat(const float* src, bf16_t* dst, size_t n8, size_t gt, size_t ngt) {
    for (size_t i = gt; i < n8; i += ngt) { const f32x4 a = *(const f32x4*)(src + i * 8), b = *(const f32x4*)(src + i * 8 + 4);
        u32x4 o; o.x = cvt_pk_bf16(a[0], a[1]); o.y = cvt_pk_bf16(a[2], a[3]); o.z = cvt_pk_bf16(b[0], b[1]); o.w = cvt_pk_bf16(b[2], b[3]);
        *(u32x4*)(dst + i * 8) = o; }
}
template <int DEPTH>
__device__ __forceinline__ void norm_rows_d(const float* x, const float* gain, bf16_t* out, int nrows, int gw, int NGW, int lane) {
    f32x4 g[4];
#pragma unroll
    for (int j = 0; j < 4; ++j) g[j] = ((const f32x4*)gain)[lane + 64 * j];
    f32x4 nx[DEPTH][4];
#pragma unroll
    for (int d = 0; d < DEPTH; ++d) { const int m = gw + d * NGW; if (m < nrows) { const f32x4* xr = (const f32x4*)(x + (size_t)m * DM) + lane;
#pragma unroll
        for (int j = 0; j < 4; ++j) nx[d][j] = xr[64 * j]; } }
    for (int m0 = gw; m0 < nrows; m0 += DEPTH * NGW) {
#pragma unroll
        for (int d = 0; d < DEPTH; ++d) { const int m = m0 + d * NGW;
            if (m < nrows) {
                f32x4 v[4]; float s = 0.f;
#pragma unroll
                for (int j = 0; j < 4; ++j) v[j] = nx[d][j];
                const int mn = m + DEPTH * NGW;
                if (mn < nrows) { const f32x4* xr = (const f32x4*)(x + (size_t)mn * DM) + lane;
#pragma unroll
                    for (int j = 0; j < 4; ++j) nx[d][j] = xr[64 * j]; }
#pragma unroll
                for (int j = 0; j < 4; ++j) s += (v[j][0] * v[j][0] + v[j][1] * v[j][1]) + (v[j][2] * v[j][2] + v[j][3] * v[j][3]);
                const float rs = rsqrtf(wave_sum(s) * (1.f / DM) + 1e-6f);
                u32x2* o8 = (u32x2*)(out + (size_t)m * DM) + lane;
#pragma unroll
                for (int j = 0; j < 4; ++j) { u32x2 o; o.x = cvt_pk_bf16(v[j][0] * rs * g[j][0], v[j][1] * rs * g[j][1]); o.y = cvt_pk_bf16(v[j][2] * rs * g[j][2], v[j][3] * rs * g[j][3]); o8[64 * j] = o; }
            }
        }
    }
}
__device__ __forceinline__ void norm_rows(const float* x, const float* gain, bf16_t* out, int nrows, int gw, int NGW, int lane) { norm_rows_d<1>(x, gain, out, nrows, gw, NGW, lane); }

__device__ __forceinline__ void attn_phase(LAS unsigned char* lds, const int tid_, const bf16_t* qkv, int g, float* Nacc, float* Zacc, bf16_t* obuf,
                                           const float* q_gain, const float* k_gain, float M2) {
    const int dsh = 2 * g, dil = 1 << dsh, L = S >> dsh;
    constexpr int KP = 144, VP = 192;
    LAS unsigned char* Kl = lds; LAS unsigned char* Vl = lds + 384 * KP;
    const bool g256 = (gridDim.x == 256);
    const int nui = g256 ? 4 : (1024 + (int)gridDim.x - 1) / (int)gridDim.x;
    u32x4 kraw[6], vraw[6], qraw[4];
#define ATT_UNIT(UI) (g256 ? ((int)(blockIdx.x & 7) * 128 + (int)(blockIdx.x >> 3) * 4 + (UI)) : ((int)blockIdx.x + (UI) * (int)gridDim.x))
#define ATT_LOAD(UN) do { const int tid2 = tid_; const int hd_ = (UN) >> 6, rw_ = ((UN) & 63) * 256, cl_ = rw_ / L, ii_ = rw_ - cl_ * L; const int c_ = tid2 & 7; \
        _Pragma("unroll") for (int it = 0; it < 6; ++it) { const int rr = (tid2 >> 3) + 64 * it; const bool ok = (ii_ - 128 + rr) >= 0; \
            const size_t grow = ok ? (size_t)(rw_ - 128 + rr) : (size_t)rw_; const bf16_t* kp = qkv + zo_ + grow * 3072 + 1024 + hd_ * 64 + c_ * 8; \
            kraw[it] = *(const u32x4*)kp; vraw[it] = *(const u32x4*)(kp + 1024); } \
        const bf16_t* qp = qkv + zo_ + (size_t)(rw_ + 32 * (tid2 >> 6) + (tid2 & 31)) * 3072 + hd_ * 64 + 8 * ((tid2 >> 5) & 1); \
        _Pragma("unroll") for (int ks = 0; ks < 4; ++ks) qraw[ks] = *(const u32x4*)(qp + 16 * ks); } while (0)
    { size_t zo_ = 0; const int u0 = ATT_UNIT(0); if (u0 < 1024) ATT_LOAD(u0); }
    for (int ui = 0; ui < nui; ++ui) {
        const int u = ATT_UNIT(ui);
        if (u >= 1024) break;
        int tid = tid_; asm volatile("" : "+v"(tid));
        const int lane = tid & 63, wid = __builtin_amdgcn_readfirstlane(tid >> 6), r32 = lane & 31, hh = lane >> 5;
        const int head = u >> 6, qb = u & 63;
        const int row0 = qb * 256, cls = row0 / L, i0 = row0 - cls * L;
        const float slope2 = exp2f(-8.f * (float)(head + 1) / 16.f) * (float)dil * LOG2E;
        BAR_LDS();
        {
            const int c = tid & 7;
            float kg[8];
#pragma unroll
            for (int j = 0; j < 8; ++j) kg[j] = k_gain[g * 64 + c * 8 + j];
#pragma unroll
            for (int it = 0; it < 6; ++it) { const int rr = (tid >> 3) + 64 * it;
                const bool ok = (i0 - 128 + rr) >= 0;
                const u32x4 kv = kraw[it]; u32x4 vv = vraw[it];
                float f[8]; f[0] = bflo(kv.x); f[1] = bfhi(kv.x); f[2] = bflo(kv.y); f[3] = bfhi(kv.y); f[4] = bflo(kv.z); f[5] = bfhi(kv.z); f[6] = bflo(kv.w); f[7] = bfhi(kv.w);
                float ss = 0.f;
#pragma unroll
                for (int j = 0; j < 8; ++j) ss += f[j] * f[j];
                ss += __shfl_xor(ss, 1); ss += __shfl_xor(ss, 2); ss += __shfl_xor(ss, 4);
                const float rs = rsqrtf(ss * (1.f / 64.f) + 1e-6f);
                u32x4 ko; ko.x = cvt_pk_bf16(f[0] * rs * kg[0], f[1] * rs * kg[1]); ko.y = cvt_pk_bf16(f[2] * rs * kg[2], f[3] * rs * kg[3]);
                ko.z = cvt_pk_bf16(f[4] * rs * kg[4], f[5] * rs * kg[5]); ko.w = cvt_pk_bf16(f[6] * rs * kg[6], f[7] * rs * kg[7]);
                if (!ok) { ko = (u32x4){0u, 0u, 0u, 0u}; vv = (u32x4){0u, 0u, 0u, 0u}; }
                *(LAS u32x4*)(Kl + rr * KP + c * 16) = ko;
                *(LAS u32x4*)(Vl + rr * VP + c * 16) = vv;
            }
        }
        bf16x8 qf[4];
        {
            float ss = 0.f;
#pragma unroll
            for (int ks = 0; ks < 4; ++ks) {
                const float a0 = bflo(qraw[ks].x), a1 = bfhi(qraw[ks].x), a2 = bflo(qraw[ks].y), a3 = bfhi(qraw[ks].y), a4 = bflo(qraw[ks].z), a5 = bfhi(qraw[ks].z), a6 = bflo(qraw[ks].w), a7 = bfhi(qraw[ks].w);
                ss += (a0 * a0 + a1 * a1) + (a2 * a2 + a3 * a3) + (a4 * a4 + a5 * a5) + (a6 * a6 + a7 * a7); }
            ss += __shfl_xor(ss, 32);
            const float rs = rsqrtf(ss * (1.f / 64.f) + 1e-6f) * (0.125f * LOG2E);
#pragma unroll
            for (int ks = 0; ks < 4; ++ks) { const float* gp = q_gain + g * 64 + 16 * ks + 8 * hh;
                u32x4 o; o.x = cvt_pk_bf16(bflo(qraw[ks].x) * rs * gp[0], bfhi(qraw[ks].x) * rs * gp[1]); o.y = cvt_pk_bf16(bflo(qraw[ks].y) * rs * gp[2], bfhi(qraw[ks].y) * rs * gp[3]);
                o.z = cvt_pk_bf16(bflo(qraw[ks].z) * rs * gp[4], bfhi(qraw[ks].z) * rs * gp[5]); o.w = cvt_pk_bf16(bflo(qraw[ks].w) * rs * gp[6], bfhi(qraw[ks].w) * rs * gp[7]);
                qf[ks] = __builtin_bit_cast(bf16x8, o); }
        }
        { size_t zo_ = 0; asm volatile("" : "+v"(zo_)); const int un = ATT_UNIT(ui + 1); if (ui + 1 < nui && un < 1024) ATT_LOAD(un); }
        const int iq = i0 + 32 * wid + r32;
        const int t = iq * dil + cls;
        float* np = Nacc + (size_t)t * DM + head * 64;
        float* zp = Zacc + (size_t)t * 16 + head;
        f32x4 nold[8]; float zold = 0.f;
        if (g > 0) { zold = *zp;
#pragma unroll
            for (int i = 0; i < 8; ++i) nold[i] = *(const f32x4*)(np + 32 * (i >> 2) + 8 * (i & 3) + 4 * hh); }
        BAR_LDS();
        f32x16 o0 = zero16(), o1 = zero16(); float zsum = 0.f;
        unsigned zl = 0; asm volatile("" : "+v"(zl) :: "memory");
        const int trow = ((lane & 15) >> 2) + 4 * hh, tcol = 16 * ((lane >> 4) & 1) + 4 * (lane & 3);
#pragma unroll 1
        for (int kt = 0; kt < 5; ++kt) {
            const int kb = 32 * wid + 32 * kt;
            f32x16 s = zero16();
            __builtin_amdgcn_s_setprio(1);
#pragma unroll
            for (int ks = 0; ks < 4; ++ks) { const bf16x8 kf = *(const LAS bf16x8*)(Kl + (kb + r32) * KP + (16 * ks + 8 * hh) * 2); s = mfma32(kf, qf[ks], s); }
            __builtin_amdgcn_s_setprio(0);
            const int ikb = i0 - 128 + kb;
            float p[16];
            const float cl = slope2 * (float)(ikb + 4 * hh - iq) - M2;
            const bool need_mask = (kt == 0) || (kt == 4) || (ikb < 0);
            if (need_mask) {
#pragma unroll
                for (int r = 0; r < 16; ++r) { const int m = (r & 3) + 8 * (r >> 2) + 4 * hh; const int ik = ikb + m; const int j = iq - ik;
                    const bool valid = (j >= 0) && (j <= 128) && (ik >= 0);
                    const float lg = s[r] + (cl + slope2 * (float)((r & 3) + 8 * (r >> 2)));
                    p[r] = valid ? __builtin_amdgcn_exp2f(lg) : 0.f; zsum += p[r]; }
            } else {
#pragma unroll
                for (int r = 0; r < 16; ++r) { const float lg = s[r] + (cl + slope2 * (float)((r & 3) + 8 * (r >> 2)));
                    p[r] = __builtin_amdgcn_exp2f(lg); zsum += p[r]; }
            }
            u32x4 pa, pb;
            pa.x = cvt_pk_bf16(p[0], p[1]); pa.y = cvt_pk_bf16(p[2], p[3]); pa.z = cvt_pk_bf16(p[4], p[5]); pa.w = cvt_pk_bf16(p[6], p[7]);
            pb.x = cvt_pk_bf16(p[8], p[9]); pb.y = cvt_pk_bf16(p[10], p[11]); pb.z = cvt_pk_bf16(p[12], p[13]); pb.w = cvt_pk_bf16(p[14], p[15]);
            const bf16x8 pf0 = __builtin_bit_cast(bf16x8, pa), pf1 = __builtin_bit_cast(bf16x8, pb);
            __builtin_amdgcn_s_setprio(1);
#pragma unroll
            for (int ksp = 0; ksp < 2; ++ksp) {
                const bf16x8 pf = ksp ? pf1 : pf0;
#pragma unroll
                for (int mt = 0; mt < 2; ++mt) {
                    LAS const unsigned char* a0 = Vl + zl + (kb + 16 * ksp + trow) * VP + (32 * mt + tcol) * 2;
                    const s16x4 lo = tr_read(a0), hi = tr_read(a0 + 8 * VP);
                    const bf16x8 vf = cat8(lo, hi);
                    if (mt == 0) o0 = mfma32(vf, pf, o0); else o1 = mfma32(vf, pf, o1);
                }
            }
            __builtin_amdgcn_s_setprio(0);
        }
        asm volatile("" : "+v"(o0), "+v"(o1) :: "memory");
        zsum += __shfl_xor(zsum, 32);
        float zt = zsum;
        if (g > 0) zt += zold;
        if (g < 2) { if (hh == 0) *zp = zt; }
        const float zinv = __builtin_amdgcn_rcpf(zt);
#pragma unroll
        for (int mt = 0; mt < 2; ++mt)
#pragma unroll
            for (int rg = 0; rg < 4; ++rg) {
                const int dim = 32 * mt + 8 * rg + 4 * hh;
                f32x4 v;
#pragma unroll
                for (int e = 0; e < 4; ++e) v[e] = mt ? o1[4 * rg + e] : o0[4 * rg + e];
                if (g > 0) v = v + nold[mt * 4 + rg];
                if (g < 2) *(f32x4*)(np + dim) = v;
                else { u32x2 o; o.x = cvt_pk_bf16(v[0] * zinv, v[1] * zinv); o.y = cvt_pk_bf16(v[2] * zinv, v[3] * zinv); *(u32x2*)(obuf + (size_t)t * DM + head * 64 + dim) = o; }
            }
    }
}


constexpr size_t WS_CARRY = 12 * MiB;
constexpr size_t WS_XM = 26 * MiB;
constexpr size_t WS_XC = 43 * MiB;
constexpr size_t WS_QB = 59 * MiB;
constexpr size_t WS_KB = 75 * MiB;
constexpr size_t WS_VB = 91 * MiB;
constexpr size_t WS_ZG = 107 * MiB;
constexpr size_t WS_ST = 171 * MiB;
constexpr size_t WS_HSEG = 236 * MiB;
constexpr size_t MS_IPRE = 4096, MS_LOGF = 4096 + 262144, MS_NST = 1 * MiB, MS_MPREV = 2 * MiB, MS_MCARRY = 2 * MiB + 4096, MS_NCARRY = 3 * MiB;
constexpr int SEG = 4096, NSEG = 4, NCH = SEG / 128;
constexpr size_t MS_GFOLD = 3 * ((size_t)1 << 20) + 262144;
constexpr float KSCALE = 0.044194173824159216f;

__device__ __forceinline__ void unpack8(const u32x4 r, float* x) { x[0] = bflo(r.x); x[1] = bfhi(r.x); x[2] = bflo(r.y); x[3] = bfhi(r.y); x[4] = bflo(r.z); x[5] = bfhi(r.z); x[6] = bflo(r.w); x[7] = bfhi(r.w); }
__device__ __forceinline__ void load_w32(const float* w, float* W) {
#pragma unroll
    for (int i = 0; i < 8; ++i) { const f32x4 v = ((const f32x4*)w)[i]; W[4 * i] = v[0]; W[4 * i + 1] = v[1]; W[4 * i + 2] = v[2]; W[4 * i + 3] = v[3]; }
}
__device__ __forceinline__ u32x4 bd8(const u32x4 raw, const float* W, float scale) {
    float x[8]; unpack8(raw, x); float o[8];
#pragma unroll
    for (int b = 0; b < 2; ++b)
#pragma unroll
        for (int k = 0; k < 4; ++k) o[4 * b + k] = (x[4 * b] * W[16 * b + k] + x[4 * b + 1] * W[16 * b + 4 + k] + x[4 * b + 2] * W[16 * b + 8 + k] + x[4 * b + 3] * W[16 * b + 12 + k]) * scale;
    u32x4 r; r.x = cvt_pk_bf16(o[0], o[1]); r.y = cvt_pk_bf16(o[2], o[3]); r.z = cvt_pk_bf16(o[4], o[5]); r.w = cvt_pk_bf16(o[6], o[7]); return r;
}
__device__ __forceinline__ u32x4 bd8dot(const u32x4 raw, const float* W, float scale, const f32x4 na, const f32x4 nb, float& dot) {
    float x[8]; unpack8(raw, x); float o[8];
#pragma unroll
    for (int b = 0; b < 2; ++b)
#pragma unroll
        for (int k = 0; k < 4; ++k) o[4 * b + k] = (x[4 * b] * W[16 * b + k] + x[4 * b + 1] * W[16 * b + 4 + k] + x[4 * b + 2] * W[16 * b + 8 + k] + x[4 * b + 3] * W[16 * b + 12 + k]) * scale;
    dot += (o[0] * na[0] + o[1] * na[1]) + (o[2] * na[2] + o[3] * na[3]) + (o[4] * nb[0] + o[5] * nb[1]) + (o[6] * nb[2] + o[7] * nb[3]);
    u32x4 r; r.x = cvt_pk_bf16(o[0], o[1]); r.y = cvt_pk_bf16(o[2], o[3]); r.z = cvt_pk_bf16(o[4], o[5]); r.w = cvt_pk_bf16(o[6], o[7]); return r;
}
__device__ __forceinline__ float wave_scan_add(float v, int lane) {
#pragma unroll
    for (int o = 1; o < 64; o <<= 1) { const float n = __shfl_up(v, o); if (lane >= o) v += n; }
    return v;
}
__device__ __forceinline__ float wave_scan_max(float v, int lane) {
#pragma unroll
    for (int o = 1; o < 64; o <<= 1) { const float n = __shfl_up(v, o); if (lane >= o) v = fmaxf(v, n); }
    return v;
}

__device__ __forceinline__ void m2_fold(const int tid, const float* wq, const float* wk, const float* wv, const float* wgate, float* gfold) {
    const int c0 = 4 * tid;
    float Wq[16], Wk[16], Wv[16], Gc[4][8], Gvv[4][8];
#pragma unroll
    for (int i = 0; i < 4; ++i) { const f32x4 a = ((const f32x4*)(wq + tid * 16))[i], b = ((const f32x4*)(wk + tid * 16))[i], c = ((const f32x4*)(wv + tid * 16))[i];
#pragma unroll
        for (int e = 0; e < 4; ++e) { Wq[4 * i + e] = a[e]; Wk[4 * i + e] = b[e]; Wv[4 * i + e] = c[e]; } }
    {
    float Gq[4][8], Gk[4][8], Gv[4][8];
#pragma unroll
    for (int c = 0; c < 4; ++c)
#pragma unroll
        for (int h2 = 0; h2 < 2; ++h2) { const f32x4 a = *(const f32x4*)(wgate + (size_t)(c0 + c) * 8 + 4 * h2), b = *(const f32x4*)(wgate + (size_t)(BIN + c0 + c) * 8 + 4 * h2), d = *(const f32x4*)(wgate + (size_t)(2 * BIN + c0 + c) * 8 + 4 * h2);
#pragma unroll
            for (int e = 0; e < 4; ++e) { Gq[c][4 * h2 + e] = a[e]; Gk[c][4 * h2 + e] = b[e]; Gv[c][4 * h2 + e] = d[e]; } }
#pragma unroll
    for (int j = 0; j < 4; ++j)
#pragma unroll
        for (int gi = 0; gi < 8; ++gi) { float a = 0.f, b = 0.f;
#pragma unroll
            for (int k = 0; k < 4; ++k) { a += Wq[4 * j + k] * Gq[k][gi] + Wk[4 * j + k] * Gk[k][gi]; b += Wv[4 * j + k] * Gv[k][gi]; }
            Gc[j][gi] = a; Gvv[j][gi] = b; }
    }
#pragma unroll
    for (int j = 0; j < 4; ++j)
#pragma unroll
        for (int gi = 0; gi < 8; ++gi) { gfold[(size_t)(j * 8 + gi) * 512 + tid] = Gc[j][gi]; gfold[(size_t)(32 + j * 8 + gi) * 512 + tid] = Gvv[j][gi]; }
}

__device__ __forceinline__ void m2_phase(LAS unsigned char* lds, const int tid, const int bx, const int G, const int seg, const bf16_t* xm, bf16_t* xc, bf16_t* qo, bf16_t* ko, bf16_t* vo, float* ipre, float* logf,
                                         const float* conv_w, const float* conv_b, const float* wq, const float* wk, const float* wv, const float* gfold, const float* bgate) {
    const int lane = tid & 63, wid = tid >> 6, c0 = 4 * tid;
#define M2_STAGE(T0) do { LAS unsigned char* xs = lds + 8192; __syncthreads(); \
        _Pragma("unroll") for (int hb = 0; hb < 2; ++hb) { u32x4 rr[5]; \
        _Pragma("unroll") for (int i = 0; i < 5; ++i) { const int e = tid + 512 * (5 * hb + i); const int row = e >> 8, cq = e & 255; if (row < 19) rr[i] = *(const u32x4*)(xm + (size_t)((T0) + row) * BIN + 8 * cq); } \
        _Pragma("unroll") for (int i = 0; i < 5; ++i) { const int e = tid + 512 * (5 * hb + i); const int row = e >> 8, cq = e & 255; if (row < 19) *(LAS u32x4*)(xs + row * 4096 + cq * 16) = rr[i]; } } \
        __syncthreads(); } while (0)
    if (bx < SEG / 16) { M2_STAGE(bx * 16); }
    float cw[4][4], cb[4], Wq[16], Wk[16], Wv[16], Gc[4][8], Gvv[4][8];
#pragma unroll
    for (int k = 0; k < 4; ++k) { const f32x4 v = *(const f32x4*)(conv_w + k * BIN + c0); cw[k][0] = v[0]; cw[k][1] = v[1]; cw[k][2] = v[2]; cw[k][3] = v[3]; }
    { const f32x4 v = *(const f32x4*)(conv_b + c0); cb[0] = v[0]; cb[1] = v[1]; cb[2] = v[2]; cb[3] = v[3]; }
#pragma unroll
    for (int i = 0; i < 4; ++i) { const f32x4 a = ((const f32x4*)(wq + tid * 16))[i], b = ((const f32x4*)(wk + tid * 16))[i], c = ((const f32x4*)(wv + tid * 16))[i];
#pragma unroll
        for (int e = 0; e < 4; ++e) { Wq[4 * i + e] = a[e]; Wk[4 * i + e] = b[e]; Wv[4 * i + e] = c[e]; } }
#pragma unroll
    for (int j = 0; j < 4; ++j)
#pragma unroll
        for (int gi = 0; gi < 8; ++gi) { Gc[j][gi] = gfold[(size_t)(j * 8 + gi) * 512 + tid]; Gvv[j][gi] = gfold[(size_t)(32 + j * 8 + gi) * 512 + tid]; }
    LAS float* part = (LAS float*)lds;
    const int b0 = lane & 1, b1 = (lane >> 1) & 1, b2 = (lane >> 2) & 1, b3 = (lane >> 3) & 1, gidx4 = 8 * b0 + 4 * b1 + 2 * b2 + b3;
    for (int u = bx; u < SEG / 16; u += G) {
        const int t0 = u * 16;
        if (u != bx) { M2_STAGE(u * 16); }
        LAS const unsigned char* xrow = lds + 8192 + c0 * 2;
#pragma unroll 1
        for (int tb = 0; tb < 16; tb += 2) {
            float gp[16];
#pragma unroll
            for (int j4 = 0; j4 < 2; ++j4) {
            const int tt = tb + j4;
            float x0[4], x1[4], x2[4], x3[4];
            { const u32x2 r0 = *(const LAS u32x2*)(xrow + tt * 4096), r1 = *(const LAS u32x2*)(xrow + (tt + 1) * 4096), r2 = *(const LAS u32x2*)(xrow + (tt + 2) * 4096), r3 = *(const LAS u32x2*)(xrow + (tt + 3) * 4096);
              x0[0] = bflo(r0.x); x0[1] = bfhi(r0.x); x0[2] = bflo(r0.y); x0[3] = bfhi(r0.y);
              x1[0] = bflo(r1.x); x1[1] = bfhi(r1.x); x1[2] = bflo(r1.y); x1[3] = bfhi(r1.y);
              x2[0] = bflo(r2.x); x2[1] = bfhi(r2.x); x2[2] = bflo(r2.y); x2[3] = bfhi(r2.y);
              x3[0] = bflo(r3.x); x3[1] = bfhi(r3.x); x3[2] = bflo(r3.y); x3[3] = bfhi(r3.y); }
            float xv[4];
#pragma unroll
            for (int c = 0; c < 4; ++c) { const float y = cb[c] + cw[0][c] * x0[c] + cw[1][c] * x1[c] + cw[2][c] * x2[c] + cw[3][c] * x3[c]; xv[c] = y * __builtin_amdgcn_rcpf(1.f + __expf(-y)); }
            { u32x2 o; o.x = cvt_pk_bf16(xv[0], xv[1]); o.y = cvt_pk_bf16(xv[2], xv[3]); *(u32x2*)(xc + (size_t)(t0 + tt) * BIN + c0) = o; }
            float q[4], kk[4], vv[4];
#pragma unroll
            for (int k = 0; k < 4; ++k) { q[k] = xv[0] * Wq[k] + xv[1] * Wq[4 + k] + xv[2] * Wq[8 + k] + xv[3] * Wq[12 + k];
                kk[k] = xv[0] * Wk[k] + xv[1] * Wk[4 + k] + xv[2] * Wk[8 + k] + xv[3] * Wk[12 + k];
                vv[k] = x3[0] * Wv[k] + x3[1] * Wv[4 + k] + x3[2] * Wv[8 + k] + x3[3] * Wv[12 + k]; }
            { const size_t o = (size_t)(t0 + tt) * BIN + c0; u32x2 w;
              w.x = cvt_pk_bf16(q[0], q[1]); w.y = cvt_pk_bf16(q[2], q[3]); *(u32x2*)(qo + o) = w;
              w.x = cvt_pk_bf16(kk[0] * KSCALE, kk[1] * KSCALE); w.y = cvt_pk_bf16(kk[2] * KSCALE, kk[3] * KSCALE); *(u32x2*)(ko + o) = w;
              w.x = cvt_pk_bf16(vv[0], vv[1]); w.y = cvt_pk_bf16(vv[2], vv[3]); *(u32x2*)(vo + o) = w; }
#pragma unroll
            for (int gi = 0; gi < 8; ++gi) { float a = 0.f;
#pragma unroll
                for (int c = 0; c < 4; ++c) a += xv[c] * Gc[c][gi] + x3[c] * Gvv[c][gi];
                gp[j4 * 8 + gi] = a; }
            }
            float h8[8], h4[4], h2[2], a1;
#pragma unroll
            for (int i = 0; i < 8; ++i) { const float send = b0 ? gp[i] : gp[8 + i]; const float recv = __shfl_xor(send, 1); h8[i] = (b0 ? gp[8 + i] : gp[i]) + recv; }
#pragma unroll
            for (int i = 0; i < 4; ++i) { const float send = b1 ? h8[i] : h8[4 + i]; const float recv = __shfl_xor(send, 2); h4[i] = (b1 ? h8[4 + i] : h8[i]) + recv; }
#pragma unroll
            for (int i = 0; i < 2; ++i) { const float send = b2 ? h4[i] : h4[2 + i]; const float recv = __shfl_xor(send, 4); h2[i] = (b2 ? h4[2 + i] : h4[i]) + recv; }
            { const float send = b3 ? h2[0] : h2[1]; const float recv = __shfl_xor(send, 8); a1 = (b3 ? h2[1] : h2[0]) + recv; }
            a1 += __shfl_xor(a1, 16); a1 += __shfl_xor(a1, 32);
            if (lane < 16) part[((tb + (gidx4 >> 3)) * 8 + wid) * 8 + (gidx4 & 7)] = a1;
        }
        __syncthreads();
        if (tid < 128) { const int tok = tid >> 3, gi = tid & 7; float v = bgate[gi];
#pragma unroll
            for (int w = 0; w < 8; ++w) v += part[(tok * 8 + w) * 8 + gi];
            const size_t tg = (size_t)seg * SEG + t0 + tok;
            if (gi < 4) ipre[tg * 4 + gi] = v; else logf[tg * 4 + gi - 4] = fminf(v, 0.f) - log1pf(__expf(-fabsf(v))); }
        __syncthreads();
    }
}

__device__ __forceinline__ u32x4 scale8(const u32x4 r, float w) {
    u32x4 o; o.x = cvt_pk_bf16(bflo(r.x) * w, bfhi(r.x) * w); o.y = cvt_pk_bf16(bflo(r.y) * w, bfhi(r.y) * w);
    o.z = cvt_pk_bf16(bflo(r.z) * w, bfhi(r.z) * w); o.w = cvt_pk_bf16(bflo(r.w) * w, bfhi(r.w) * w); return o;
}
__device__ __forceinline__ void m3_phase(LAS unsigned char* lds, const int tid_, const int bx, const int G, const int seg, const bf16_t* kb, const bf16_t* vb, const float* ipre, const float* logf,
                                         bf16_t* states, float* nstates, float* mprev_g, float* mcarry, float* carryC, float* ncarry) {
    constexpr int KP = 144;
    LAS float* a_s = (LAS float*)lds;
    LAS float* bl = (LAS float*)(lds + 32768); LAS float* am = bl + 64; LAS float* Al = bl + 128; LAS float* dec = bl + 192;
    LAS unsigned char* Kt = lds + 36864;
    for (int u = bx; u < 256; u += G) {
        int tid = tid_; asm volatile("" : "+v"(tid));
        const int lane = tid & 63, wid = __builtin_amdgcn_readfirstlane(tid >> 6), r32 = lane & 31, hh = lane >> 5;
        const int xcd = u & 7, idx = u >> 3;
        const int head = xcd >> 1, dt = (xcd & 1) * 4 + (idx >> 3), et = idx & 7;
        __syncthreads();
        for (int c = wid; c < NCH; c += 8) {
            const size_t tg = (size_t)seg * SEG + c * 128 + 2 * lane;
            const float lf0 = logf[tg * 4 + head], lf1 = logf[(tg + 1) * 4 + head], i0 = ipre[tg * 4 + head], i1 = ipre[(tg + 1) * 4 + head];
            const float ps = lf0 + lf1; const float incl = wave_scan_add(ps, lane);
            const float bb0 = incl - lf1, bb1 = incl; const float a0 = i0 - bb0, a1 = i1 - bb1;
            const float amax = wave_max(fmaxf(a0, a1)); const float blast = __shfl(incl, 63);
            a_s[c * 128 + 2 * lane] = a0; a_s[c * 128 + 2 * lane + 1] = a1;
            if (lane == 0) { bl[c] = blast; am[c] = amax; }
        }
        __syncthreads();
        if (wid == 0) {
            const float amr = (lane < NCH) ? am[lane] : 0.f, blr = (lane < NCH) ? bl[lane] : 0.f;
            float m = (seg == 0) ? -1e30f : mcarry[4 * seg + head];
            m = __int_as_float(__builtin_amdgcn_readfirstlane(__float_as_int(m)));
            float myA = 0.f, myd = 0.f, mym = 0.f;
#pragma unroll
            for (int c = 0; c < NCH; ++c) { const float amc = __int_as_float(__builtin_amdgcn_readlane(__float_as_int(amr), c)), blc = __int_as_float(__builtin_amdgcn_readlane(__float_as_int(blr), c));
                const float A = fmaxf(m, amc); const float d = __expf(m - A);
                if (lane == c) { myA = A; myd = d; mym = m; }
                m = blc + A; }
            if (lane < NCH) { Al[lane] = myA; dec[lane] = myd; if (dt == 0 && et == 0) mprev_g[(seg * NCH + lane) * 4 + head] = mym; }
            if (lane == 0 && dt == 0 && et == 0 && seg + 1 < NSEG) mcarry[4 * (seg + 1) + head] = m;
        }
        __syncthreads();
        const int cc = tid & 7, rowp = tid >> 3;
        const int kch = head * 512 + dt * 64 + 8 * cc, vch = head * 512 + et * 64 + 8 * cc;
        const int mt = wid & 1, nt = (wid >> 1) & 1; const bool do_n = (et == 0) && (wid < 2);
        f32x16 accC = zero16(), nacc = zero16();
        const int dbase = dt * 64 + 32 * mt + 4 * hh, ecol = et * 64 + 32 * nt + r32;
        if (seg > 0 && wid < 4) {
#pragma unroll
            for (int r = 0; r < 16; ++r) { const int d = dbase + (r & 3) + 8 * (r >> 2); accC[r] = carryC[((size_t)head * 512 + d) * 512 + ecol]; if (do_n) nacc[r] = ncarry[head * 512 + d]; }
        }
        bf16x8 ones;
#pragma unroll
        for (int i = 0; i < 8; ++i) ones[i] = (short)0x3F80;
        const int q4 = (lane & 15) >> 2, tcol = 16 * ((lane >> 4) & 1) + 4 * (lane & 3);
        LAS unsigned char* Sn = lds + 110592;
        if (wid < 4) {
#pragma unroll
            for (int r = 0; r < 16; ++r) { const int dl = 32 * mt + 4 * hh + (r & 3) + 8 * (r >> 2);
                *(LAS unsigned short*)(Sn + dl * KP + (32 * nt + r32) * 2) = (unsigned short)(cvt_pk_bf16(accC[r], 0.f) & 0xffffu); }
        }
        const bf16_t* xk0 = kb + (size_t)rowp * BIN + kch; const bf16_t* xv0 = vb + (size_t)rowp * BIN + vch;
        u32x4 pk[4][2], pv[4][2];
#pragma unroll
        for (int j = 0; j < 4; ++j)
#pragma unroll
            for (int hf = 0; hf < 2; ++hf) { pk[j][hf] = *(const u32x4*)(xk0 + (size_t)(128 * j + 64 * hf) * BIN); pv[j][hf] = *(const u32x4*)(xv0 + (size_t)(128 * j + 64 * hf) * BIN); }
#pragma unroll 1
        for (int c4 = 0; c4 < NCH; c4 += 4) {
#pragma unroll
          for (int j = 0; j < 4; ++j) {
            const int c = c4 + j;
            size_t zo = 0; asm volatile("" : "+v"(zo));
            LAS unsigned char* Kb = Kt + (c & 1) * (256 * KP); LAS unsigned char* Vb = Kb + 128 * KP;
            const float Ac = Al[c];
#pragma unroll
            for (int hf = 0; hf < 2; ++hf) { const int row = rowp + 64 * hf;
                const float wsc = __expf(a_s[c * 128 + row] - Ac);
                *(LAS u32x4*)(Kb + row * KP + cc * 16) = scale8(pk[j][hf], wsc);
                *(LAS u32x4*)(Vb + row * KP + cc * 16) = pv[j][hf]; }
            const int cn = (c + 4 < NCH) ? c + 4 : NCH - 1;
#pragma unroll
            for (int hf = 0; hf < 2; ++hf) {
                pk[j][hf] = *(const u32x4*)(xk0 + zo + (size_t)(cn * 128 + 64 * hf) * BIN); pv[j][hf] = *(const u32x4*)(xv0 + zo + (size_t)(cn * 128 + 64 * hf) * BIN); }
            BAR_LDS();
            {   const u32x4 sv = *(const LAS u32x4*)(Sn + (c & 1) * (64 * KP) + rowp * KP + cc * 16);
                *(u32x4*)(states + zo + ((size_t)(c * 4 + head) * 512 + dt * 64 + rowp) * 512 + et * 64 + cc * 8) = sv; }
            if (wid < 4) {
                if (do_n && r32 == 0) {
#pragma unroll
                    for (int r = 0; r < 16; ++r) { const int d = dbase + (r & 3) + 8 * (r >> 2); nstates[(size_t)(c * 4 + head) * 512 + d] = nacc[r]; } }
                unsigned zl = 0; asm volatile("" : "+v"(zl) :: "memory");
                const float dc = dec[c];
#pragma unroll
                for (int r = 0; r < 16; ++r) { accC[r] *= dc; nacc[r] *= dc; }
#pragma unroll
                for (int ks = 0; ks < 8; ++ks) {
                    LAS const unsigned char* ka = Kb + zl + (16 * ks + 8 * hh + q4) * KP + (32 * mt + tcol) * 2;
                    LAS const unsigned char* va = Vb + zl + (16 * ks + 8 * hh + q4) * KP + (32 * nt + tcol) * 2;
                    const bf16x8 af = cat8(tr_read(ka), tr_read(ka + 4 * KP));
                    const bf16x8 bf = cat8(tr_read(va), tr_read(va + 4 * KP));
                    accC = mfma32(af, bf, accC);
                    nacc = mfma32(af, ones, nacc);
                }
                asm volatile("" : "+v"(accC), "+v"(nacc) :: "memory");
                LAS unsigned char* Sw = Sn + ((c + 1) & 1) * (64 * KP);
#pragma unroll
                for (int r = 0; r < 16; ++r) { const int dl = 32 * mt + 4 * hh + (r & 3) + 8 * (r >> 2);
                    *(LAS unsigned short*)(Sw + dl * KP + (32 * nt + r32) * 2) = (unsigned short)(cvt_pk_bf16(accC[r], 0.f) & 0xffffu); }
            }
          }
        }
        if (seg + 1 < NSEG && wid < 4) {
#pragma unroll
            for (int r = 0; r < 16; ++r) { const int d = dbase + (r & 3) + 8 * (r >> 2); carryC[((size_t)head * 512 + d) * 512 + ecol] = accC[r]; if (do_n && r32 == 0) ncarry[head * 512 + d] = nacc[r]; }
        }
    }
}

__device__ __forceinline__ void m4_phase(LAS unsigned char* lds, const int tid_, const int bx, const int G, const int seg, const bf16_t* qb, const bf16_t* kb, const bf16_t* vb, const bf16_t* xc, bf16_t* zg,
                                         const float* ipre, const float* logf, const bf16_t* states, const float* nstates, const float* mprev_g, const float* hgain, const float* skip) {
    constexpr int KP = 144, PP = 272, BP = 1088;
    LAS float* sa = (LAS float*)lds; LAS float* sA = sa + 128; LAS float* smt = sa + 256; LAS float* ssc = sa + 384; LAS float* sden = sa + 512; LAS float* sssq = sa + 640; LAS float* sdenp = sa + 1152;
    LAS unsigned char* PL = lds + 8192; LAS unsigned char* QS = lds + 43008; LAS unsigned char* KS = lds + 61440; LAS unsigned char* BT = lds + 61440;
    for (int u = bx; u < NCH * 8; u += G) {
        int tid = tid_; asm volatile("" : "+v"(tid));
        const int lane = tid & 63, wid = __builtin_amdgcn_readfirstlane(tid >> 6), r32 = lane & 31, hh = lane >> 5;
        const int q4 = (lane & 15) >> 2, tcol = 16 * ((lane >> 4) & 1) + 4 * (lane & 3);
        const bool xmap = (G == 256 && NCH * 8 == 256);
        const int xq = u & 7, jq = u >> 3, pairidx = xq * 16 + (jq >> 1);
        const int half = xmap ? (jq & 1) : (u & 1), c = xmap ? (pairidx >> 2) : (u >> 3), head = xmap ? (pairidx & 3) : ((u >> 1) & 3);
        const size_t rbase = (size_t)c * 128;
        __syncthreads();
        if (wid == 0) {
            const size_t tg = (size_t)seg * SEG + c * 128 + 2 * lane;
            const float lf0 = logf[tg * 4 + head], lf1 = logf[(tg + 1) * 4 + head], i0 = ipre[tg * 4 + head], i1 = ipre[(tg + 1) * 4 + head];
            const float incl = wave_scan_add(lf0 + lf1, lane);
            const float bb0 = incl - lf1, bb1 = incl; const float a0 = i0 - bb0, a1 = i1 - bb1;
            const float mp = mprev_g[(seg * NCH + c) * 4 + head];
            const float inclm = wave_scan_max(fmaxf(a0, a1), lane); float exclm = __shfl_up(inclm, 1); if (lane == 0) exclm = -3e38f;
            const float A0 = fmaxf(mp, fmaxf(exclm, a0)), A1 = fmaxf(mp, inclm);
            sa[2 * lane] = a0; sa[2 * lane + 1] = a1; sA[2 * lane] = A0; sA[2 * lane + 1] = A1; smt[2 * lane] = bb0 + A0; smt[2 * lane + 1] = bb1 + A1;
            ssc[2 * lane] = __expf(mp - A0); ssc[2 * lane + 1] = __expf(mp - A1);
            sdenp[2 * lane] = 0.f; sdenp[2 * lane + 1] = 0.f;
        }
        __syncthreads();
        const int cc = tid & 7, rowp = tid >> 3;
        const int trow = 64 * half + rowp;
        const int chh = head * 512 + 8 * cc;
        {
            const int st = wid & 3, tt = 2 * half + (wid >> 2);
            f32x16 s0 = zero16();
            u32x4 rq = *(const u32x4*)(qb + (rbase + trow) * BIN + chh), rk0 = *(const u32x4*)(kb + (rbase + rowp) * BIN + chh), rk1 = *(const u32x4*)(kb + (rbase + rowp + 64) * BIN + chh);
#pragma unroll 1
            for (int ds_ = 0; ds_ < 8; ++ds_) {
                int ds = ds_; asm volatile("" : "+s"(ds));
                size_t zo = 0; asm volatile("" : "+v"(zo));
                *(LAS u32x4*)(QS + rowp * KP + cc * 16) = rq;
                *(LAS u32x4*)(KS + rowp * KP + cc * 16) = rk0;
                *(LAS u32x4*)(KS + (rowp + 64) * KP + cc * 16) = rk1;
                { const int dn = (ds + 1 < 8) ? ds + 1 : 7;
                  rq = *(const u32x4*)(qb + zo + (rbase + trow) * BIN + chh + dn * 64);
                  rk0 = *(const u32x4*)(kb + zo + (rbase + rowp) * BIN + chh + dn * 64);
                  rk1 = *(const u32x4*)(kb + zo + (rbase + rowp + 64) * BIN + chh + dn * 64); }
                BAR_LDS();
#pragma unroll
                for (int ks = 0; ks < 4; ++ks) { const bf16x8 kf = *(const LAS bf16x8*)(KS + (32 * st + r32) * KP + (16 * ks + 8 * hh) * 2);
                    const bf16x8 q0 = *(const LAS bf16x8*)(QS + (32 * (wid >> 2) + r32) * KP + (16 * ks + 8 * hh) * 2);
                    s0 = mfma32(kf, q0, s0); }
                BAR_LDS();
            }
            { const int t = 32 * tt + r32; const float At = sA[t]; float psum = 0.f;
#pragma unroll
                for (int rg = 0; rg < 4; ++rg) { float p[4];
#pragma unroll
                    for (int e = 0; e < 4; ++e) { const int sidx = 32 * st + 8 * rg + 4 * hh + e; const float sv = s0[4 * rg + e];
                        p[e] = (sidx <= t) ? sv * __expf(sa[sidx] - At) : 0.f; psum += p[e]; }
                    u32x2 o; o.x = cvt_pk_bf16(p[0], p[1]); o.y = cvt_pk_bf16(p[2], p[3]);
                    *(LAS u32x2*)(PL + t * PP + (32 * st + 8 * rg + 4 * hh) * 2) = o; }
                psum += __shfl_xor(psum, 32);
                if (hh == 0) atomicAdd((float*)(sdenp + t), psum);
            }
        }
        {
            const int mt = (wid & 1) + 2 * half, nt0 = wid >> 1;
            f32x16 acc[4];
#pragma unroll
            for (int i = 0; i < 4; ++i) acc[i] = zero16();
            float dq0 = 0.f;
            u32x4 btA[8], btB[8], rqA = (u32x4){0u, 0u, 0u, 0u}, rqB = rqA; f32x4 naA = (f32x4){0.f, 0.f, 0.f, 0.f}, nbA = naA, naB = naA, nbB = naA;
#define M4_LOAD(SL, BT_, RQ_, NA_, NB_) do { size_t zo_ = 0; asm volatile("" : "+v"(zo_)); const bf16_t* src_; \
                if ((SL) < 8) { const float* np8 = nstates + zo_ + (size_t)(c * 4 + head) * 512 + (SL) * 64 + 8 * cc; NA_ = *(const f32x4*)np8; NB_ = *(const f32x4*)(np8 + 4); \
                    RQ_ = *(const u32x4*)(qb + zo_ + (rbase + trow) * BIN + chh + (SL) * 64); \
                    src_ = states + zo_ + (((size_t)(c * 4 + head) * 512) + (SL) * 64 + rowp) * 512; } \
                else src_ = vb + zo_ + (rbase + ((SL) - 8) * 64 + rowp) * BIN + head * 512; \
                _Pragma("unroll") for (int i_ = 0; i_ < 8; ++i_) BT_[i_] = *(const u32x4*)(src_ + 8 * (cc + 8 * i_)); } while (0)
#define M4_ROUND(SL, BT_, RQ_, NA_, NB_) do { \
                BAR_LDS(); \
                if ((SL) < 8) { const float sc = ssc[trow]; float x[8]; unpack8(RQ_, x); \
                    _Pragma("unroll") for (int j = 0; j < 8; ++j) x[j] *= sc; \
                    dq0 += (x[0] * NA_[0] + x[1] * NA_[1]) + (x[2] * NA_[2] + x[3] * NA_[3]) + (x[4] * NB_[0] + x[5] * NB_[1]) + (x[6] * NB_[2] + x[7] * NB_[3]); \
                    u32x4 o; o.x = cvt_pk_bf16(x[0], x[1]); o.y = cvt_pk_bf16(x[2], x[3]); o.z = cvt_pk_bf16(x[4], x[5]); o.w = cvt_pk_bf16(x[6], x[7]); \
                    *(LAS u32x4*)(QS + rowp * KP + cc * 16) = o; } \
                _Pragma("unroll") for (int i = 0; i < 8; ++i) *(LAS u32x4*)(BT + rowp * BP + (cc + 8 * i) * 16) = BT_[i]; \
                if ((SL) + 2 < 10) M4_LOAD((SL) + 2, BT_, RQ_, NA_, NB_); \
                BAR_LDS(); \
                unsigned zl = 0; asm volatile("" : "+v"(zl) :: "memory"); \
                LAS const unsigned char* abase = (((SL) < 8) ? (QS + (32 * (wid & 1) + r32) * KP + 16 * hh) : (PL + (32 * mt + r32) * PP + (64 * ((SL) - 8) + 8 * hh) * 2)) + zl; \
                _Pragma("unroll") for (int ks = 0; ks < 4; ++ks) { \
                    const bf16x8 af = *(const LAS bf16x8*)(abase + 32 * ks); \
                    LAS const unsigned char* b0p = BT + zl + (16 * ks + 8 * hh + q4) * BP + tcol * 2; \
                    _Pragma("unroll") for (int i = 0; i < 4; ++i) { LAS const unsigned char* bp = b0p + (32 * (nt0 + 4 * i)) * 2; \
                        const bf16x8 bf = cat8(tr_read(bp), tr_read(bp + 4 * BP)); acc[i] = mfma32(af, bf, acc[i]); } } \
                asm volatile("" : "+v"(acc[0]), "+v"(acc[1]), "+v"(acc[2]), "+v"(acc[3]) :: "memory"); } while (0)
            M4_LOAD(0, btA, rqA, naA, nbA);
            M4_LOAD(1, btB, rqB, naB, nbB);
#pragma unroll 1
            for (int sl_ = 0; sl_ < 10; sl_ += 2) {
                int sl = sl_; asm volatile("" : "+s"(sl));
                M4_ROUND(sl, btA, rqA, naA, nbA);
                M4_ROUND(sl + 1, btB, rqB, naB, nbB);
            }
            dq0 += __shfl_xor(dq0, 1); dq0 += __shfl_xor(dq0, 2); dq0 += __shfl_xor(dq0, 4);
            if (cc == 0) sden[trow] = dq0;
            BAR_LDS();
#pragma unroll
            for (int r = 0; r < 16; ++r) { const int t = 32 * mt + (r & 3) + 8 * (r >> 2) + 4 * hh;
                const float dn = fmaxf(fabsf(sden[t] + sdenp[t]), __expf(-smt[t])); const float inv = __builtin_amdgcn_rcpf(dn); float q = 0.f;
#pragma unroll
                for (int i = 0; i < 4; ++i) { acc[i][r] *= inv; q += acc[i][r] * acc[i][r]; }
                q += __shfl_xor(q, 1); q += __shfl_xor(q, 2); q += __shfl_xor(q, 4); q += __shfl_xor(q, 8); q += __shfl_xor(q, 16);
                if (r32 == 0) sssq[nt0 * 128 + t] = q; }
            BAR_LDS();
#pragma unroll
            for (int i = 0; i < 4; ++i) { const int e = 32 * (nt0 + 4 * i) + r32; const int ch = head * 512 + e; const float hgv = hgain[ch], skv = skip[ch];
#pragma unroll
                for (int r = 0; r < 16; ++r) { const int t = 32 * mt + (r & 3) + 8 * (r >> 2) + 4 * hh;
                    const float rstd = rsqrtf(((sssq[t] + sssq[128 + t]) + (sssq[256 + t] + sssq[384 + t])) * (1.f / 512.f) + 1e-6f);
                    const size_t ro = (rbase + t) * BIN + ch;
                    const size_t rz = ((size_t)seg * SEG + rbase + t) * BIN + ch;
                    const float xcv = bf2f(xc[ro]), zv = bf2f(zg[rz]);
                    const float o = (acc[i][r] * rstd * hgv + skv * xcv) * (zv * __builtin_amdgcn_rcpf(1.f + __expf(-zv)));
                    zg[rz] = (bf16_t)(cvt_pk_bf16(o, 0.f) & 0xffffu); }
                asm volatile("" ::: "memory");
            }
        }
    }
}

#define XB_TMO      128
#define XB_XCNT(j)  (256  + 64 * (j))
#define XB_XSUB(j)  (1280 + 64 * (j))
#define XB_XGEN(j)  (2304 + 64 * (j))
#define XB_TOP      3328
#define XB_TOPGEN   3392
#define XCD_BAR_WORDS 3456
#define XB_SPIN_CAP (1u << 22)
__device__ __forceinline__ unsigned xb_ld(unsigned* p)              { return __hip_atomic_load(p, __ATOMIC_RELAXED, __HIP_MEMORY_SCOPE_AGENT); }
__device__ __forceinline__ unsigned xb_add(unsigned* p, unsigned v) { return __hip_atomic_fetch_add(p, v, __ATOMIC_RELAXED, __HIP_MEMORY_SCOPE_AGENT); }
__device__ __forceinline__ unsigned xb_xcc_id() { return (unsigned)__builtin_amdgcn_s_getreg((3 << 11) | 20) & 0xFu; }
#define XB_SPIN(cond, bar) do { unsigned _sp = 0; while (cond) { __builtin_amdgcn_s_sleep(1); \
    if ((++_sp & 255u) == 0u) { if (xb_ld(&(bar)[XB_TMO])) break; if (_sp > XB_SPIN_CAP) { atomicAdd(&(bar)[XB_TMO], 1u); break; } } } } while (0)
struct XcdBarrier { unsigned* bar; unsigned x; volatile LAS unsigned* st; };
__device__ __forceinline__ XcdBarrier xcd_barrier_post(unsigned* bar, volatile LAS unsigned* st) {
    XcdBarrier b; b.bar = bar; b.x = xb_xcc_id(); b.st = st;
    if (threadIdx.x == 0) (void)xb_add(&bar[XB_XCNT(b.x)], 1u);
    return b;
}
__device__ __forceinline__ void xcd_barrier_complete(unsigned* bar, unsigned x, unsigned& nloc, unsigned& nx) {
    const unsigned G = gridDim.x * gridDim.y * gridDim.z;
    unsigned sum, cnt, mine, sp = 0u;
    for (;;) {
        sum = 0u; cnt = 0u; mine = 0u;
#pragma unroll
        for (unsigned j = 0; j < 16; ++j) { const unsigned c = xb_ld(&bar[XB_XCNT(j)]); sum += c; cnt += (c > 0u) ? 1u : 0u; mine = (j == x) ? c : mine; }
        if (sum == G) break;
        __builtin_amdgcn_s_sleep(1);
        if ((++sp & 255u) == 0u) { if (xb_ld(&bar[XB_TMO])) break; if (sp > XB_SPIN_CAP) { atomicAdd(&bar[XB_TMO], 1u); break; } }
    }
    nloc = mine > 0u ? mine : 1u; nx = cnt > 0u ? cnt : 1u;
}
__device__ __forceinline__ void xcd_barrier(const XcdBarrier& b) {
    asm volatile("s_waitcnt vmcnt(0)" ::: "memory");
    __syncthreads();
    if (threadIdx.x == 0) {
        unsigned* bar = b.bar;
        __builtin_amdgcn_s_waitcnt(0);
        unsigned nloc = b.st[0], nx = b.st[1];
        if (nloc == 0u) { xcd_barrier_complete(bar, b.x, nloc, nx); b.st[0] = nloc; b.st[1] = nx; }
        const unsigned old = xb_add(&bar[XB_XSUB(b.x)], 1u);
        const unsigned gen = old / nloc;
        if (old + 1u == (gen + 1u) * nloc) {
            __builtin_amdgcn_fence(__ATOMIC_RELEASE, "agent");
            asm volatile("s_waitcnt vmcnt(0)" ::: "memory");
            const unsigned og = xb_add(&bar[XB_TOP], 1u);
            const unsigned tg = og / nx;
            if (og + 1u == (tg + 1u) * nx) xb_add(&bar[XB_TOPGEN], 1u);
            else XB_SPIN(xb_ld(&bar[XB_TOPGEN]) == tg, bar);
            __builtin_amdgcn_fence(__ATOMIC_ACQUIRE, "agent");
            xb_add(&bar[XB_XGEN(b.x)], 1u);
            asm volatile("s_waitcnt vmcnt(0)" ::: "memory");
        } else {
            XB_SPIN(xb_ld(&bar[XB_XGEN(b.x)]) == gen, bar);
            __builtin_amdgcn_fence(__ATOMIC_ACQUIRE, "agent");
            asm volatile("s_waitcnt vmcnt(0)" ::: "memory");
        }
    }
    __syncthreads();
}
constexpr size_t MS_BAR = 3 * ((size_t)1 << 20) + 65536;

__global__ void __launch_bounds__(512, 2) mega(Params P) {
    extern __shared__ __attribute__((aligned(16))) unsigned char lds_raw[];
    LAS unsigned char* lds = (LAS unsigned char*)lds_raw;
    cg::grid_group grid = cg::this_grid();
    const int G_ = gridDim.x, bx_ = blockIdx.x;
    unsigned char* ws_ = P.ws;
    float* xres_ = P.out;
    int ph = 0;
    XcdBarrier xbar; xbar.bar = nullptr; xbar.x = 0; xbar.st = nullptr;
    if (threadIdx.x < 2) ((volatile LAS unsigned*)(lds + 131072 + 64))[threadIdx.x] = 0u;
    __syncthreads();
#if !MULTI_LAUNCH
    xbar = xcd_barrier_post((unsigned*)(ws_ + WS_MISC + MS_BAR), (volatile LAS unsigned*)(lds + 131072 + 64));
#endif
#if MULTI_LAUNCH
#define OPAQUE unsigned char* ws = ws_; float* xres = xres_; int tid = threadIdx.x; int bx = bx_, G = G_; size_t zopq = 0; asm volatile("" : "+s"(zopq), "+v"(tid), "+s"(bx), "+s"(G)); ws += zopq; xres += zopq; float* misc = (float*)(ws + WS_MISC); \
    const int lane = tid & 63, wid = __builtin_amdgcn_readfirstlane(tid >> 6); const int gw = bx * 8 + wid, NGW = G * 8; const size_t gt = (size_t)bx * 512 + tid, ngt = (size_t)G * 512; \
    LAS float* scr = (LAS float*)(lds + wid * 16384); (void)misc; (void)xres; (void)lane; (void)gw; (void)NGW; (void)gt; (void)ngt; (void)scr;
#define PH_BEGIN if (ph >= P.ph_lo && ph < P.ph_hi) { OPAQUE
#define PH_END } ++ph;
#define PH_END_IF(c) } ++ph;
#else
#define OPAQUE unsigned char* ws = ws_; float* xres = xres_; int tid = threadIdx.x; int bx = bx_, G = G_; size_t zopq = 0; asm volatile("" : "+s"(zopq), "+v"(tid), "+s"(bx), "+s"(G)); ws += zopq; xres += zopq; float* misc = (float*)(ws + WS_MISC); \
    const int lane = tid & 63, wid = __builtin_amdgcn_readfirstlane(tid >> 6); const int gw = bx * 8 + wid, NGW = G * 8; const size_t gt = (size_t)bx * 512 + tid, ngt = (size_t)G * 512; \
    LAS float* scr = (LAS float*)(lds + wid * 16384); (void)misc; (void)xres; (void)lane; (void)gw; (void)NGW; (void)gt; (void)ngt; (void)scr;
#define PH_END_IF(c) if (c) xcd_barrier(xbar); } ++ph;
#define PH_BEGIN { OPAQUE
#define PH_END xcd_barrier(xbar); } ++ph;
#endif

    for (int layer = 0; layer < 2; ++layer) {
        const float* w1 = as_global(P.in[I_MW1]) + (size_t)layer * DM * DFF; const float* w2 = as_global(P.in[I_MW2]) + (size_t)layer * DFF * DM;
        const float* wg = as_global(P.in[I_PWG]) + (size_t)layer * DM * DM; const float* wp = as_global(P.in[I_PWP]) + (size_t)layer * PLE * DM;
        const float* pin = as_global(P.in[I_P]) + (size_t)layer * S * PLE;
        if (layer == 0) {
            PH_BEGIN
                convert_mat(as_global(P.in[I_AWQKV]), DM, 9216, (bf16_t*)(ws + W_QKV), scr, gw, NGW, lane);
                convert_mat(as_global(P.in[I_AWO]), DM, DM, (bf16_t*)(ws + W_O), scr, gw, NGW, lane);
                convert_mat(w1, DM, DFF, (bf16_t*)(ws + W_1), scr, gw, NGW, lane);
                convert_mat(w2, DFF, DM, (bf16_t*)(ws + W_2), scr, gw, NGW, lane);
                convert_mat(wg, DM, DM, (bf16_t*)(ws + W_G), scr, gw, NGW, lane);
                convert_mat(wp, PLE, DM, (bf16_t*)(ws + W_P), scr, gw, NGW, lane);
                convert_flat(pin, (bf16_t*)(ws + WS_PB), (size_t)S * PLE / 8, gt, ngt);
                if (bx == 0 && wid == 0) { float mq = 0.f, mk = 0.f;
                    for (int i = lane; i < 192; i += 64) { mq = fmaxf(mq, fabsf(as_global(P.in[I_AQG])[i])); mk = fmaxf(mk, fabsf(as_global(P.in[I_AKG])[i])); }
                    mq = wave_max(mq); mk = wave_max(mk); if (lane == 0) misc[0] = 8.f * mq * mk * LOG2E * 1.02f; }
                norm_rows_d<4>(as_global(P.in[I_X]), as_global(P.in[I_ANORM]), (bf16_t*)(ws + WS_H), S, gw, NGW, lane);
            PH_END
            for (int g = 0; g < 3; ++g) {
                PH_BEGIN
                    pg8::Gemm gm{(const bf16_t*)(ws + WS_H), (const bf16_t*)(ws + W_QKV) + (size_t)g * 3072 * DM, S, 3072, DM};
                    pg8::StaticOrder so; so.init(S, 3072, G, bx);
                    EpiBf16<0> E{(bf16_t*)(ws + WS_QKV), 3072, 2 * g, S, 0, nullptr, 0};
                    pg8::gemm_phase<EpiBf16<0>, pg8::StaticOrder>(lds, tid, gm, so, E);
                PH_END
                PH_BEGIN
                    attn_phase(lds, tid, (const bf16_t*)(ws + WS_QKV), g, (float*)(ws + WS_NACC), (float*)(ws + WS_Z), (bf16_t*)(ws + WS_H), as_global(P.in[I_AQG]), as_global(P.in[I_AKG]), misc[0]);
                PH_END
            }
            PH_BEGIN
                pg8::Gemm gm{(const bf16_t*)(ws + WS_H), (const bf16_t*)(ws + W_O), S, DM, DM};
                pg8::StaticOrder so; so.init(S, DM, G, bx);
                EpiF32<1> E{xres, as_global(P.in[I_X]), nullptr, DM};
                pg8::gemm_phase<EpiF32<1>, pg8::StaticOrder>(lds, tid, gm, so, E);
            PH_END
        } else {
            PH_BEGIN
                convert_mat_np(as_global(P.in[I_BWUP]), DM, 2 * BIN, (bf16_t*)(ws + W_UP), scr, gw, NGW, lane);
                convert_mat_np(as_global(P.in[I_BWDOWN]), BIN, DM, (bf16_t*)(ws + W_DOWN), scr, gw, NGW, lane);
                if (bx == 0) { for (int i = tid; i < 3 * BIN / 8; i += 512) ((u32x4*)(ws + WS_XM))[i] = (u32x4){0u, 0u, 0u, 0u}; }
                if (bx == 1 % G) m2_fold(tid, as_global(P.in[I_BWQ]), as_global(P.in[I_BWK]), as_global(P.in[I_BWV]), as_global(P.in[I_BWG]), misc + MS_GFOLD / 4);
                norm_rows(xres, as_global(P.in[I_BNORM]), (bf16_t*)(ws + WS_HSEG), SEG, gw, NGW, lane);
            PH_END
            PH_BEGIN
                pg8::Gemm gm{(const bf16_t*)(ws + WS_HSEG), (const bf16_t*)(ws + W_UP), SEG, 2 * BIN, DM};
                pg8::StaticOrder so; so.init(SEG, 2 * BIN, G, bx);
                EpiBf16<0> E{(bf16_t*)(ws + WS_XM) + 3 * BIN, BIN, 0, SEG, 8, (bf16_t*)(ws + WS_ZG), 0};
                pg8::gemm_phase<EpiBf16<0>, pg8::StaticOrder>(lds, tid, gm, so, E);
            PH_END
            for (int seg = 0; seg < NSEG; ++seg) {
                PH_BEGIN
                    m2_phase(lds, tid, bx, G, seg, (const bf16_t*)(ws + WS_XM), (bf16_t*)(ws + WS_XC), (bf16_t*)(ws + WS_QB), (bf16_t*)(ws + WS_KB), (bf16_t*)(ws + WS_VB), misc + MS_IPRE / 4, misc + MS_LOGF / 4,
                             as_global(P.in[I_BCW]), as_global(P.in[I_BCB]), as_global(P.in[I_BWQ]), as_global(P.in[I_BWK]), as_global(P.in[I_BWV]), misc + MS_GFOLD / 4, as_global(P.in[I_BBG]));
                PH_END
                PH_BEGIN
                    if (seg + 1 < NSEG) norm_rows(xres + (size_t)(seg + 1) * SEG * DM, as_global(P.in[I_BNORM]), (bf16_t*)(ws + WS_HSEG), SEG, gw, NGW, lane);
                    m3_phase(lds, tid, bx, G, seg, (const bf16_t*)(ws + WS_KB), (const bf16_t*)(ws + WS_VB), misc + MS_IPRE / 4, misc + MS_LOGF / 4,
                             (bf16_t*)(ws + WS_ST), misc + MS_NST / 4, misc + MS_MPREV / 4, misc + MS_MCARRY / 4, (float*)(ws + WS_CARRY), misc + MS_NCARRY / 4);
                    if (seg + 1 < NSEG && bx == G - 1) { for (int i = tid; i < 3 * BIN / 8; i += 512) ((u32x4*)(ws + WS_XM))[i] = ((const u32x4*)(ws + WS_XM + (size_t)SEG * BIN * 2))[i]; }
                PH_END
                PH_BEGIN
                    m4_phase(lds, tid, bx, G, seg, (const bf16_t*)(ws + WS_QB), (const bf16_t*)(ws + WS_KB), (const bf16_t*)(ws + WS_VB), (const bf16_t*)(ws + WS_XC), (bf16_t*)(ws + WS_ZG), misc + MS_IPRE / 4, misc + MS_LOGF / 4,
                             (const bf16_t*)(ws + WS_ST), misc + MS_NST / 4, misc + MS_MPREV / 4, as_global(P.in[I_BHG]), as_global(P.in[I_BSKIP]));
                    if (seg + 1 < NSEG) {
                        __syncthreads();
                        pg8::Gemm gm{(const bf16_t*)(ws + WS_HSEG), (const bf16_t*)(ws + W_UP), SEG, 2 * BIN, DM};
                        pg8::StaticOrder so; so.init(SEG, 2 * BIN, G, bx);
                        EpiBf16<0> E{(bf16_t*)(ws + WS_XM) + 3 * BIN, BIN, 0, SEG, 8, (bf16_t*)(ws + WS_ZG) + (size_t)(seg + 1) * SEG * BIN, 0};
                        pg8::gemm_phase<EpiBf16<0>, pg8::StaticOrder>(lds, tid, gm, so, E);
                    }
                PH_END
            }
            PH_BEGIN
                pg8::Gemm gm{(const bf16_t*)(ws + WS_ZG), (const bf16_t*)(ws + W_DOWN), S, DM, BIN};
                pg8::StaticOrder so; so.init(S, DM, G, bx);
                EpiF32<1> E{xres, xres, nullptr, DM};
                pg8::gemm_phase<EpiF32<1>, pg8::StaticOrder>(lds, tid, gm, so, E);
            PH_END
        }
        PH_BEGIN
            if (layer == 1) {
                convert_mat_np(w1, DM, DFF, (bf16_t*)(ws + W_1), scr, gw, NGW, lane);
                convert_mat_np(w2, DFF, DM, (bf16_t*)(ws + W_2), scr, gw, NGW, lane);
                convert_mat_np(wg, DM, DM, (bf16_t*)(ws + W_G), scr, gw, NGW, lane);
                convert_mat_np(wp, PLE, DM, (bf16_t*)(ws + W_P), scr, gw, NGW, lane);
                convert_flat(pin, (bf16_t*)(ws + WS_PB), (size_t)S * PLE / 8, gt, ngt);
            }
            norm_rows_d<4>(xres, as_global(P.in[I_MNORM]) + layer * DM, (bf16_t*)(ws + WS_H), S, gw, NGW, lane);
        PH_END
        PH_BEGIN
            pg8::Gemm gm{(const bf16_t*)(ws + WS_H), (const bf16_t*)(ws + W_1), S, DFF, DM};
            pg8::StaticOrder so; so.init(S, DFF, G, bx);
            EpiBf16<1> E{(bf16_t*)(ws + WS_HID), DFF, 0, S, 0, nullptr, 0};
            pg8::gemm_phase<EpiBf16<1>, pg8::StaticOrder>(lds, tid, gm, so, E);
        PH_END
        PH_BEGIN
            pg8::Gemm gm{(const bf16_t*)(ws + WS_HID), (const bf16_t*)(ws + W_2), S, DM, DFF};
            pg8::StaticOrder so; so.init(S, DM, G, bx);
            EpiF32<1> E{xres, xres, nullptr, DM};
            pg8::gemm_phase<EpiF32<1>, pg8::StaticOrder>(lds, tid, gm, so, E);
        PH_END
        PH_BEGIN
            norm_rows_d<4>(xres, as_global(P.in[I_PNORM]) + layer * DM, (bf16_t*)(ws + WS_H), S, gw, NGW, lane);
        PH_END
        PH_BEGIN
            {   pg8::Gemm gm{(const bf16_t*)(ws + WS_PB), (const bf16_t*)(ws + W_P), S, DM, PLE};
                pg8::StaticOrder so; so.init(S, DM, G, bx);
                EpiBf16<0> E{(bf16_t*)(ws + WS_PE), DM, 0, S, 0, nullptr, 0};
                pg8::gemm_phase<EpiBf16<0>, pg8::StaticOrder>(lds, tid, gm, so, E); }
            {   pg8::Gemm gm{(const bf16_t*)(ws + WS_H), (const bf16_t*)(ws + W_G), S, DM, DM};
                pg8::StaticOrder so; so.init(S, DM, G, bx);
                EpiF32<2> E{xres, xres, (const float*)(ws + WS_PE), DM};
                pg8::gemm_phase<EpiF32<2>, pg8::StaticOrder>(lds, tid, gm, so, E); }
        PH_END_IF(layer == 0)
    }
}

constexpr int NPHASES = 1 + 6 + 1 + 5 + 15 + 5;

extern "C" void kernel_launch(void* const* d_in, const int* in_sizes, int n_in, void* d_out, int out_size, void* d_ws, size_t ws_size, hipStream_t stream) {
    static int grid = 0;
    if (grid == 0) {
        if (n_in != 25 || ws_size < WS_END) { fprintf(stderr, "kernel_launch: unexpected n_in %d / ws %zu\n", n_in, ws_size); grid = -1; return; }
        int dev = 0, cus = 0, per_cu = 0;
        hipGetDevice(&dev); hipDeviceGetAttribute(&cus, hipDeviceAttributeMultiprocessorCount, dev);
        hipFuncSetAttribute((const void*)mega, hipFuncAttributeMaxDynamicSharedMemorySize, LDS_BYTES);
        hipOccupancyMaxActiveBlocksPerMultiprocessor(&per_cu, (const void*)mega, 512, LDS_BYTES);
        if (per_cu < 1) { fprintf(stderr, "kernel_launch: occupancy query says %d blocks/CU\n", per_cu); per_cu = 1; }
        (void)hipGetLastError();
        grid = cus * 1;
    }
    if (grid < 0) return;
    Params p{};
    for (int i = 0; i < 25; ++i) p.in[i] = (const float*)d_in[i];
    p.out = (float*)d_out; p.ws = (unsigned char*)d_ws;
#if MULTI_LAUNCH
    for (int ph = 0; ph < NPHASES; ++ph) { p.ph_lo = ph; p.ph_hi = ph + 1; hipLaunchKernelGGL(mega, dim3(grid), dim3(512), LDS_BYTES, stream, p); }
#else
    p.ph_lo = 0; p.ph_hi = NPHASES;
    if (hipMemsetAsync((unsigned char*)d_ws + WS_MISC + MS_BAR, 0, XCD_BAR_WORDS * 4, stream) != hipSuccess) { fprintf(stderr, "kernel_launch: memset of the barrier words failed\n"); return; }
    void* args[] = {&p};
    hipError_t e = hipLaunchCooperativeKernel((const void*)mega, dim3(grid), dim3(512), args, LDS_BYTES, stream);
    if (e != hipSuccess) fprintf(stderr, "cooperative launch failed: %s (grid %d)\n", hipGetErrorString(e), grid);
#endif
}
```

```cpp
#include <hip/hip_runtime.h>
#include <hip/hip_cooperative_groups.h>
#include <cstdio>
namespace cg = cooperative_groups;

#ifndef MULTI_LAUNCH
#define MULTI_LAUNCH 0
#endif

#define LAS __attribute__((address_space(3)))
typedef unsigned short bf16_t;
typedef short bf16x8 __attribute__((ext_vector_type(8)));
typedef short s16x4 __attribute__((ext_vector_type(4)));
typedef float f32x4 __attribute__((ext_vector_type(4)));
typedef float f32x2 __attribute__((ext_vector_type(2)));
typedef float f32x16 __attribute__((ext_vector_type(16)));
typedef unsigned u32x4 __attribute__((ext_vector_type(4)));
typedef unsigned u32x2 __attribute__((ext_vector_type(2)));

#define GAS __attribute__((address_space(1)))
template <class T> __device__ __forceinline__ T* as_global(T* p) { return p; }
#define LDS_WAIT() asm volatile("s_waitcnt lgkmcnt(0)" ::: "memory")
#define BAR_LDS() do { asm volatile("s_waitcnt lgkmcnt(0)" ::: "memory"); __builtin_amdgcn_s_barrier(); asm volatile("" ::: "memory"); } while (0)

__device__ __forceinline__ unsigned cvt_pk_bf16(float lo, float hi) { unsigned r; asm("v_cvt_pk_bf16_f32 %0, %1, %2" : "=v"(r) : "v"(lo), "v"(hi)); return r; }
__device__ __forceinline__ float bf2f(unsigned short b) { return __uint_as_float(((unsigned)b) << 16); }
__device__ __forceinline__ float bflo(unsigned u) { return __uint_as_float(u << 16); }
__device__ __forceinline__ float bfhi(unsigned u) { return __uint_as_float(u & 0xffff0000u); }
__device__ __forceinline__ float wave_sum(float v) {
#pragma unroll
    for (int o = 1; o < 64; o <<= 1) v += __shfl_xor(v, o);
    return v;
}
__device__ __forceinline__ float wave_max(float v) {
#pragma unroll
    for (int o = 1; o < 64; o <<= 1) v = fmaxf(v, __shfl_xor(v, o));
    return v;
}
__device__ __forceinline__ f32x16 mfma32(bf16x8 a, bf16x8 b, f32x16 c) { return __builtin_amdgcn_mfma_f32_32x32x16_bf16(a, b, c, 0, 0, 0); }
typedef short v4i16_t __attribute__((ext_vector_type(4)));
__device__ __forceinline__ s16x4 tr_read(LAS const unsigned char* p) { return __builtin_bit_cast(s16x4, __builtin_amdgcn_ds_read_tr16_b64_v4i16((LAS v4i16_t*)p)); }
__device__ __forceinline__ bf16x8 cat8(s16x4 a, s16x4 b) { return (bf16x8){a[0], a[1], a[2], a[3], b[0], b[1], b[2], b[3]}; }
__device__ __forceinline__ f32x16 zero16() { f32x16 z;
#pragma unroll
    for (int i = 0; i < 16; ++i) z[i] = 0.f; return z; }

namespace pg8 {
constexpr int BM = 256, BK = 64, HALF = 128, HTB = HALF * BK * 2, STAGE_BYTES = 8 * HTB, NXCD = 8, WGM = 8;
__host__ __device__ __forceinline__ int lds_byte(int r, int c) { const int st = (r >> 4) * 2 + (c >> 5), rr = r & 15, cc = c & 31, ob = rr * 64 + cc * 2; return st * 1024 + (ob ^ (((ob >> 9) & 1) << 5)); }
__host__ __device__ __forceinline__ void stage_rc(int b, int& R, int& C) { const int st = b / 1024, sb = b % 1024, swz = sb ^ (((sb >> 9) & 1) << 5); R = (st >> 1) * 16 + swz / 64; C = (st & 1) * 32 + (swz % 64) / 2; }
__host__ __device__ __forceinline__ int perm32(int rho) { const int n = rho >> 4, i = rho & 15; return 8 * (i >> 2) + 4 * n + (i & 3); }
struct Unit { int pm, pn; };
struct Gemm { const bf16_t* A; const bf16_t* Bt; int M, N, K; };
struct StaticOrder {
    int nM, nN, nwg, G, c;
    __host__ __device__ void init(int M, int N, int G_, int c_) { nM = M / BM; nN = N / BM; nwg = nM * nN; G = G_; c = c_; }
    __host__ __device__ bool next(int i, Unit& u) const {
        const long L = (long)i * G + c; if (L >= nwg) return false;
        int wgid = (int)L; { const int q = nwg / NXCD, r = nwg % NXCD, xcd = wgid % NXCD, off = wgid / NXCD; wgid = (xcd < r ? xcd * (q + 1) : r * (q + 1) + (xcd - r) * q) + off; }
        const int nig = WGM * nN, gid = wgid / nig, fm = gid * WGM, gsz = (nM - fm) < WGM ? (nM - fm) : WGM;
        u.pm = fm + ((wgid % nig) % gsz); u.pn = (wgid % nig) / gsz; return true;
    }
    __device__ __forceinline__ void a_ready(const Unit&) const {}
    __device__ __forceinline__ void done(const Unit&) const {}
};

template <class Epi, class Sched>
__device__ __forceinline__ void gemm_phase(LAS unsigned char* lds, const int tid, const Gemm g, const Sched& S, const Epi& E) {
    const int wid = __builtin_amdgcn_readfirstlane(tid >> 6), lane = tid & 63, wr = wid >> 2, wc = wid & 3, fr = lane & 15, fq = lane >> 4;
    const int K = g.K, nt = K / BK;
    unsigned voffA[2], voffB[2];
#pragma unroll
    for (int i = 0; i < 2; ++i) { int R, C; stage_rc(tid * 16 + i * 8192, R, C); const int Rb = Epi::PERM ? ((R & ~31) + perm32(R & 31)) : R;
        voffA[i] = (unsigned)(R * K + C) * 2u; voffB[i] = (unsigned)(Rb * K + C) * 2u; }
    const size_t kstep = (size_t)(BK * 2);
    const size_t hstep = (size_t)HALF * K * 2;
    const size_t tstep = 2 * hstep;
    const unsigned ldsw = (unsigned)wid * 1024u;
    const int aoff = lds_byte(wr * 64 + fr, fq * 8), boff = lds_byte(wc * 32 + fr, fq * 8);
#define PG8_SA(b, h) (((b) * 2 + (h)) * HTB)
#define PG8_SB(b, h) ((4 + (b) * 2 + (h)) * HTB)
#define PG8_STAGE(bufoff, gbase, voff) do { _Pragma("unroll") for (int _i = 0; _i < 2; ++_i) \
        __builtin_amdgcn_global_load_lds((const unsigned*)((const char*)(gbase) + (voff)[_i]), (LAS unsigned*)(lds + (bufoff) + ldsw + _i * 8192), 16, 0, 0); } while (0)
#define PG8_LDA(dst, b, h) do { _Pragma("unroll") for (int m = 0; m < 4; ++m) _Pragma("unroll") for (int k = 0; k < 2; ++k) dst[m][k] = *(const LAS bf16x8*)(lds + PG8_SA(b, h) + aoff + m * 2048 + k * 1024); } while (0)
#define PG8_LDB(dst, b, h) do { _Pragma("unroll") for (int n = 0; n < 2; ++n) _Pragma("unroll") for (int k = 0; k < 2; ++k) dst[n][k] = *(const LAS bf16x8*)(lds + PG8_SB(b, h) + boff + n * 2048 + k * 1024); } while (0)
#define PG8_MMA(ai, bj, At, Bt) do { __builtin_amdgcn_s_setprio(1); _Pragma("unroll") for (int m = 0; m < 4; ++m) _Pragma("unroll") for (int n = 0; n < 2; ++n) _Pragma("unroll") for (int k = 0; k < 2; ++k) \
        acc[ai][bj][m][n] = __builtin_amdgcn_mfma_f32_16x16x32_bf16(Bt[n][k], At[m][k], acc[ai][bj][m][n], 0, 0, 0); __builtin_amdgcn_s_setprio(0); } while (0)
#define PG8_WAIT_V(n) asm volatile("s_waitcnt vmcnt(" #n ")" ::: "memory")
#define PG8_WAIT_L(n) asm volatile("s_waitcnt lgkmcnt(" #n ")" ::: "memory")
#define PG8_BAR __builtin_amdgcn_s_barrier()
#define PG8_SCHED __builtin_amdgcn_sched_barrier(0)
    Unit cur, nxt; int ui = 0;
    if (!S.next(0, cur)) return;
    f32x4 acc[2][2][4][2];
#pragma unroll
    for (int a = 0; a < 2; ++a)
#pragma unroll
        for (int b = 0; b < 2; ++b)
#pragma unroll
            for (int m = 0; m < 4; ++m)
#pragma unroll
                for (int n = 0; n < 2; ++n) acc[a][b][m][n] = (f32x4){0.f, 0.f, 0.f, 0.f};
    bf16x8 At[4][2], B0[2][2], B1[2][2];
    const char* cA = (const char*)g.A + (size_t)cur.pm * tstep; const char* cB = (const char*)g.Bt + (size_t)cur.pn * tstep;
    S.a_ready(cur);
    PG8_STAGE(PG8_SB(0, 0), cB, voffB); PG8_STAGE(PG8_SA(0, 0), cA, voffA); PG8_STAGE(PG8_SB(0, 1), cB + hstep, voffB); PG8_STAGE(PG8_SA(0, 1), cA + hstep, voffA);
    if (wr == 1) PG8_BAR;
    PG8_WAIT_V(4); PG8_BAR;
    PG8_STAGE(PG8_SB(1, 0), cB + kstep, voffB); PG8_STAGE(PG8_SA(1, 0), cA + kstep, voffA); PG8_STAGE(PG8_SB(1, 1), cB + hstep + kstep, voffB);
    PG8_WAIT_V(6); PG8_BAR;
    for (;;) {
        const bool has_next = S.next(ui + 1, nxt);
        const char* nA = has_next ? (const char*)g.A + (size_t)nxt.pm * tstep : cA; const char* nB = has_next ? (const char*)g.Bt + (size_t)nxt.pn * tstep : cB;
        for (int t = 0; t < nt; t += 2) {
            const bool last = (t == nt - 2);
            const char* a1 = cA + (size_t)(t + 1) * kstep;
            const char* a2 = last ? nA : cA + (size_t)(t + 2) * kstep; const char* b2 = last ? nB : cB + (size_t)(t + 2) * kstep;
            const char* a3 = a2 + kstep; const char* b3 = b2 + kstep;
            if (last && has_next) S.a_ready(nxt);
            PG8_LDB(B0, 0, 0); PG8_SCHED; PG8_LDA(At, 0, 0); PG8_STAGE(PG8_SA(1, 1), a1 + hstep, voffA);
            PG8_WAIT_L(8); PG8_BAR; PG8_WAIT_L(0); PG8_MMA(0, 0, At, B0); PG8_BAR; PG8_SCHED;
            PG8_LDB(B1, 0, 1); PG8_STAGE(PG8_SB(0, 0), b2, voffB);
            PG8_BAR; PG8_WAIT_L(0); PG8_MMA(0, 1, At, B1); PG8_BAR;
            PG8_LDA(At, 0, 1); PG8_STAGE(PG8_SA(0, 0), a2, voffA);
            PG8_BAR; PG8_WAIT_L(0); PG8_MMA(1, 0, At, B0); PG8_BAR; PG8_SCHED;
            PG8_STAGE(PG8_SB(0, 1), b2 + hstep, voffB);
            PG8_WAIT_V(6); PG8_BAR; PG8_MMA(1, 1, At, B1); PG8_BAR;
            PG8_LDB(B0, 1, 0); PG8_SCHED; PG8_LDA(At, 1, 0); PG8_STAGE(PG8_SA(0, 1), a2 + hstep, voffA);
            PG8_WAIT_L(8); PG8_BAR; PG8_WAIT_L(0); PG8_MMA(0, 0, At, B0); PG8_BAR; PG8_SCHED;
            PG8_LDB(B1, 1, 1); PG8_STAGE(PG8_SB(1, 0), b3, voffB);
            PG8_BAR; PG8_WAIT_L(0); PG8_MMA(0, 1, At, B1); PG8_BAR;
            PG8_LDA(At, 1, 1); PG8_STAGE(PG8_SA(1, 0), a3, voffA);
            PG8_BAR; PG8_WAIT_L(0); PG8_MMA(1, 0, At, B0); PG8_BAR; PG8_SCHED;
            PG8_STAGE(PG8_SB(1, 1), b3 + hstep, voffB);
            PG8_WAIT_V(6); PG8_BAR; PG8_MMA(1, 1, At, B1); PG8_BAR;
        }
        E(acc, cur, wr, wc, fr, fq); S.done(cur);
        if (!has_next) break;
#pragma unroll
        for (int a = 0; a < 2; ++a)
#pragma unroll
            for (int b = 0; b < 2; ++b)
#pragma unroll
                for (int m = 0; m < 4; ++m)
#pragma unroll
                    for (int n = 0; n < 2; ++n) acc[a][b][m][n] = (f32x4){0.f, 0.f, 0.f, 0.f};
        cur = nxt; cA = nA; cB = nB; ++ui;
    }
    PG8_WAIT_V(0);
    if (wr == 0) PG8_BAR;
    PG8_BAR;
#undef PG8_SA
#undef PG8_SB
#undef PG8_STAGE
#undef PG8_LDA
#undef PG8_LDB
#undef PG8_MMA
#undef PG8_WAIT_V
#undef PG8_WAIT_L
#undef PG8_BAR
#undef PG8_SCHED
}
}

typedef f32x4 AccT[2][2][4][2];

template <int ACT> struct EpiBf16 {
    static constexpr bool PERM = true;
    bf16_t* O; int ldc; int dsh; int Ltot;
    int split_tile; bf16_t* O2; size_t rowoff2;
    __device__ __forceinline__ void operator()(const AccT& acc, const pg8::Unit& u, int wr, int wc, int fr, int fq) const {
        const int row0 = u.pm * 256 + wr * 64 + fr; int colt = u.pn * 256; bf16_t* base = O;
        if (split_tile && u.pn >= split_tile) { base = O2; colt -= split_tile * 256; }
        const int col0 = colt + wc * 32 + 8 * fq;
        const int dm = (1 << dsh) - 1, L = Ltot >> dsh;
#pragma unroll
        for (int ai = 0; ai < 2; ++ai)
#pragma unroll
            for (int m = 0; m < 4; ++m) {
                const int r = row0 + ai * 128 + m * 16; const int dr = (r & dm) * L + (r >> dsh);
                bf16_t* rowp = base + (size_t)dr * ldc + col0;
#pragma unroll
                for (int bj = 0; bj < 2; ++bj) { f32x4 v0 = acc[ai][bj][m][0], v1 = acc[ai][bj][m][1];
                    if (ACT == 1) {
#pragma unroll
                        for (int e = 0; e < 4; ++e) { float a = fmaxf(v0[e], 0.f); v0[e] = a * a; float b = fmaxf(v1[e], 0.f); v1[e] = b * b; } }
                    u32x4 o; o.x = cvt_pk_bf16(v0[0], v0[1]); o.y = cvt_pk_bf16(v0[2], v0[3]); o.z = cvt_pk_bf16(v1[0], v1[1]); o.w = cvt_pk_bf16(v1[2], v1[3]);
                    *(u32x4*)(rowp + bj * 128) = o; }
            }
    }
};
template <int MODE> struct EpiF32 {
    static constexpr bool PERM = false;
    static constexpr int DEPTH = (MODE == 2) ? 2 : 3;
    float* C; const float* R; const float* PE; int ldc;
    __device__ __forceinline__ void operator()(const AccT& acc, const pg8::Unit& u, int wr, int wc, int fr, int fq) const {
        const int row0 = u.pm * 256 + wr * 64 + fr, col0 = u.pn * 256 + wc * 32 + 4 * fq;
        f32x4 rn[DEPTH][4]; u32x2 pn_[DEPTH][4];
        if (MODE != 0) {
#pragma unroll
            for (int d = 0; d < DEPTH; ++d) { const size_t ro = (size_t)(row0 + (d >> 2) * 128 + (d & 3) * 16) * ldc + col0;
#pragma unroll
                for (int q = 0; q < 4; ++q) { const size_t o = ro + (q >> 1) * 128 + (q & 1) * 16; rn[d][q] = *(const f32x4*)(R + o); if (MODE == 2) pn_[d][q] = *(const u32x2*)((const bf16_t*)PE + o); } }
        }
#pragma unroll
        for (int g8 = 0; g8 < 8; ++g8) { const int ai = g8 >> 2, m = g8 & 3, sl = g8 % DEPTH;
            const size_t ro = (size_t)(row0 + ai * 128 + m * 16) * ldc + col0;
            f32x4 rc[4]; u32x2 pc[4];
#pragma unroll
            for (int q = 0; q < 4; ++q) { rc[q] = rn[sl][q]; pc[q] = pn_[sl][q]; }
            if (MODE != 0 && g8 + DEPTH < 8) { const int ai2 = (g8 + DEPTH) >> 2, m2 = (g8 + DEPTH) & 3; const size_t ro2 = (size_t)(row0 + ai2 * 128 + m2 * 16) * ldc + col0;
#pragma unroll
                for (int q = 0; q < 4; ++q) { const size_t o = ro2 + (q >> 1) * 128 + (q & 1) * 16; rn[sl][q] = *(const f32x4*)(R + o); if (MODE == 2) pn_[sl][q] = *(const u32x2*)((const bf16_t*)PE + o); } }
#pragma unroll
            for (int q = 0; q < 4; ++q) { const int bj = q >> 1, n = q & 1; const size_t o = ro + bj * 128 + n * 16; f32x4 v = acc[ai][bj][m][n];
                if (MODE == 1) { v = v + rc[q]; }
                if (MODE == 2) { f32x4 pe; pe[0] = bflo(pc[q].x); pe[1] = bfhi(pc[q].x); pe[2] = bflo(pc[q].y); pe[3] = bfhi(pc[q].y);
#pragma unroll
                    for (int e = 0; e < 4; ++e) v[e] = rc[q][e] + pe[e] * __builtin_amdgcn_rcpf(1.f + __expf(-v[e])); }
                *(f32x4*)(C + o) = v; }
        }
    }
};

constexpr int S = 16384, DM = 1024, DFF = 4096, PLE = 256, BIN = 2048;
constexpr size_t MiB = (size_t)1 << 20;
constexpr size_t WS_MISC = 0;
constexpr size_t WS_W = 4 * MiB;
constexpr size_t W_QKV = WS_W, W_UP = WS_W, W_O = WS_W + 18 * MiB, W_DOWN = WS_W + 18 * MiB, W_1 = WS_W + 22 * MiB, W_2 = WS_W + 30 * MiB, W_G = WS_W + 38 * MiB, W_P = WS_W + 40 * MiB;
constexpr size_t WS_PB = 45 * MiB;
constexpr size_t WS_H = 60 * MiB;
constexpr size_t WS_QKV = 92 * MiB;
constexpr size_t WS_NACC = 188 * MiB;
constexpr size_t WS_Z = 252 * MiB;
constexpr size_t WS_HID = 92 * MiB;
constexpr size_t WS_PE = 92 * MiB;
constexpr size_t WS_END = 256 * MiB;
constexpr int LDS_BYTES = 147456;
constexpr float LOG2E = 1.4426950408889634f;

struct Params { const float* in[25]; float* out; unsigned char* ws; int ph_lo, ph_hi; };
enum { I_X = 0, I_P, I_ANORM, I_AWQKV, I_AQG, I_AKG, I_AWO, I_BNORM, I_BWUP, I_BCW, I_BCB, I_BWQ, I_BWK, I_BWV, I_BWG, I_BBG, I_BHG, I_BSKIP, I_BWDOWN, I_MNORM, I_MW1, I_MW2, I_PNORM, I_PWG, I_PWP };

__device__ __forceinline__ void ti_load(const float* W, int N, int item, int lane, float* r) {
    const int nblk = N / 32, kb = item / nblk, nb = item % nblk, k0 = 64 * kb, n0 = 32 * nb;
#pragma unroll
    for (int i = 0; i < 32; ++i) { const int kk = 2 * i + (lane >> 5); r[i] = W[(size_t)(k0 + kk) * N + n0 + (lane & 31)]; }
}
__device__ __forceinline__ void ti_put(const float* r, LAS float* scr, int lane) {
#pragma unroll
    for (int i = 0; i < 32; ++i) { const int kk = 2 * i + (lane >> 5); scr[kk * 33 + (lane & 31)] = r[i]; }
    LDS_WAIT();
}
__device__ __forceinline__ void ti_out(int K, int N, bf16_t* WT, LAS float* scr, int item, int lane) {
    const int nblk = N / 32, kb = item / nblk, nb = item % nblk, k0 = 64 * kb, n0 = 32 * nb;
    const int c = lane & 7;
#pragma unroll
    for (int j = 0; j < 4; ++j) { const int n = (lane >> 3) + 8 * j; const LAS float* s = scr + (8 * c) * 33 + n;
        u32x4 o; o.x = cvt_pk_bf16(s[0 * 33], s[1 * 33]); o.y = cvt_pk_bf16(s[2 * 33], s[3 * 33]); o.z = cvt_pk_bf16(s[4 * 33], s[5 * 33]); o.w = cvt_pk_bf16(s[6 * 33], s[7 * 33]);
        *(u32x4*)(WT + (size_t)(n0 + n) * K + k0 + 8 * c) = o; }
    LDS_WAIT();
}
__device__ __forceinline__ void convert_mat(const float* W, int K, int N, bf16_t* WT, LAS float* scr, int gw, int NGW, int lane) {
    const int nitems = (K / 64) * (N / 32);
    float r[32];
    if (gw < nitems) ti_load(W, N, gw, lane, r);
    for (int it = gw; it < nitems; it += NGW) {
        ti_put(r, scr, lane);
        if (it + NGW < nitems) ti_load(W, N, it + NGW, lane, r);
        ti_out(K, N, WT, scr, it, lane);
    }
}
__device__ __forceinline__ void convert_mat_np(const float* W, int K, int N, bf16_t* WT, LAS float* scr, int gw, int NGW, int lane) {
    const int nitems = (K / 64) * (N / 32);
    for (int it = gw; it < nitems; it += NGW) { float r[32]; ti_load(W, N, it, lane, r); ti_put(r, scr, lane); ti_out(K, N, WT, scr, it, lane); }
}
__device__ __forceinline__ void convert_flat(const float* src, bf16_t* dst, size_t n8, size_t gt, size_t ngt) {
    for (size_t i = gt; i < n8; i += ngt) { const f32x4 a = *(const f32x4*)(src + i * 8), b = *(const f32x4*)(src + i * 8 + 4);
        u32x4 o; o.x = cvt_pk_bf16(a[0], a[1]); o.y = cvt_pk_bf16(a[2], a[3]); o.z = cvt_pk_bf16(b[0], b[1]); o.w = cvt_pk_bf16(b[2], b[3]);
        *(u32x4*)(dst + i * 8) = o; }
}
template <int DEPTH>
__device__ __forceinline__ void norm_rows_d(const float* x, const float* gain, bf16_t* out, int nrows, int gw, int NGW, int lane) {
    f32x4 g[4];
#pragma unroll
    for (int j = 0; j < 4; ++j) g[j] = ((const f32x4*)gain)[lane + 64 * j];
    f32x4 nx[DEPTH][4];
#pragma unroll
    for (int d = 0; d < DEPTH; ++d) { const int m = gw + d * NGW; if (m < nrows) { const f32x4* xr = (const f32x4*)(x + (size_t)m * DM) + lane;
#pragma unroll
        for (int j = 0; j < 4; ++j) nx[d][j] = xr[64 * j]; } }
    for (int m0 = gw; m0 < nrows; m0 += DEPTH * NGW) {
#pragma unroll
        for (int d = 0; d < DEPTH; ++d) { const int m = m0 + d * NGW;
            if (m < nrows) {
                f32x4 v[4]; float s = 0.f;
#pragma unroll
                for (int j = 0; j < 4; ++j) v[j] = nx[d][j];
                const int mn = m + DEPTH * NGW;
                if (mn < nrows) { const f32x4* xr = (const f32x4*)(x + (size_t)mn * DM) + lane;
#pragma unroll
                    for (int j = 0; j < 4; ++j) nx[d][j] = xr[64 * j]; }
#pragma unroll
                for (int j = 0; j < 4; ++j) s += (v[j][0] * v[j][0] + v[j][1] * v[j][1]) + (v[j][2] * v[j][2] + v[j][3] * v[j][3]);
                const float rs = rsqrtf(wave_sum(s) * (1.f / DM) + 1e-6f);
                u32x2* o8 = (u32x2*)(out + (size_t)m * DM) + lane;
#pragma unroll
                for (int j = 0; j < 4; ++j) { u32x2 o; o.x = cvt_pk_bf16(v[j][0] * rs * g[j][0], v[j][1] * rs * g[j][1]); o.y = cvt_pk_bf16(v[j][2] * rs * g[j][2], v[j][3] * rs * g[j][3]); o8[64 * j] = o; }
            }
        }
    }
}
__device__ __forceinline__ void norm_rows(const float* x, const float* gain, bf16_t* out, int nrows, int gw, int NGW, int lane) { norm_rows_d<1>(x, gain, out, nrows, gw, NGW, lane); }

__device__ __forceinline__ void attn_phase(LAS unsigned char* lds, const int tid_, const bf16_t* qkv, int g, float* Nacc, float* Zacc, bf16_t* obuf,
                                           const float* q_gain, const float* k_gain, float M2) {
    const int dsh = 2 * g, dil = 1 << dsh, L = S >> dsh;
    constexpr int KP = 144, VP = 192;
    LAS unsigned char* Kl = lds; LAS unsigned char* Vl = lds + 384 * KP;
    const bool g256 = (gridDim.x == 256);
    const int nui = g256 ? 4 : (1024 + (int)gridDim.x - 1) / (int)gridDim.x;
    u32x4 kraw[6], vraw[6], qraw[4];
#define ATT_UNIT(UI) (g256 ? ((int)(blockIdx.x & 7) * 128 + (int)(blockIdx.x >> 3) * 4 + (UI)) : ((int)blockIdx.x + (UI) * (int)gridDim.x))
#define ATT_LOAD(UN) do { const int tid2 = tid_; const int hd_ = (UN) >> 6, rw_ = ((UN) & 63) * 256, cl_ = rw_ / L, ii_ = rw_ - cl_ * L; const int c_ = tid2 & 7; \
        _Pragma("unroll") for (int it = 0; it < 6; ++it) { const int rr = (tid2 >> 3) + 64 * it; const bool ok = (ii_ - 128 + rr) >= 0; \
            const size_t grow = ok ? (size_t)(rw_ - 128 + rr) : (size_t)rw_; const bf16_t* kp = qkv + zo_ + grow * 3072 + 1024 + hd_ * 64 + c_ * 8; \
            kraw[it] = *(const u32x4*)kp; vraw[it] = *(const u32x4*)(kp + 1024); } \
        const bf16_t* qp = qkv + zo_ + (size_t)(rw_ + 32 * (tid2 >> 6) + (tid2 & 31)) * 3072 + hd_ * 64 + 8 * ((tid2 >> 5) & 1); \
        _Pragma("unroll") for (int ks = 0; ks < 4; ++ks) qraw[ks] = *(const u32x4*)(qp + 16 * ks); } while (0)
    { size_t zo_ = 0; const int u0 = ATT_UNIT(0); if (u0 < 1024) ATT_LOAD(u0); }
    for (int ui = 0; ui < nui; ++ui) {
        const int u = ATT_UNIT(ui);
        if (u >= 1024) break;
        int tid = tid_; asm volatile("" : "+v"(tid));
        const int lane = tid & 63, wid = __builtin_amdgcn_readfirstlane(tid >> 6), r32 = lane & 31, hh = lane >> 5;
        const int head = u >> 6, qb = u & 63;
        const int row0 = qb * 256, cls = row0 / L, i0 = row0 - cls * L;
        const float slope2 = exp2f(-8.f * (float)(head + 1) / 16.f) * (float)dil * LOG2E;
        BAR_LDS();
        {
            const int c = tid & 7;
            float kg[8];
#pragma unroll
            for (int j = 0; j < 8; ++j) kg[j] = k_gain[g * 64 + c * 8 + j];
#pragma unroll
            for (int it = 0; it < 6; ++it) { const int rr = (tid >> 3) + 64 * it;
                const bool ok = (i0 - 128 + rr) >= 0;
                const u32x4 kv = kraw[it]; u32x4 vv = vraw[it];
                float f[8]; f[0] = bflo(kv.x); f[1] = bfhi(kv.x); f[2] = bflo(kv.y); f[3] = bfhi(kv.y); f[4] = bflo(kv.z); f[5] = bfhi(kv.z); f[6] = bflo(kv.w); f[7] = bfhi(kv.w);
                float ss = 0.f;
#pragma unroll
                for (int j = 0; j < 8; ++j) ss += f[j] * f[j];
                ss += __shfl_xor(ss, 1); ss += __shfl_xor(ss, 2); ss += __shfl_xor(ss, 4);
                const float rs = rsqrtf(ss * (1.f / 64.f) + 1e-6f);
                u32x4 ko; ko.x = cvt_pk_bf16(f[0] * rs * kg[0], f[1] * rs * kg[1]); ko.y = cvt_pk_bf16(f[2] * rs * kg[2], f[3] * rs * kg[3]);
                ko.z = cvt_pk_bf16(f[4] * rs * kg[4], f[5] * rs * kg[5]); ko.w = cvt_pk_bf16(f[6] * rs * kg[6], f[7] * rs * kg[7]);
                if (!ok) { ko = (u32x4){0u, 0u, 0u, 0u}; vv = (u32x4){0u, 0u, 0u, 0u}; }
                *(LAS u32x4*)(Kl + rr * KP + c * 16) = ko;
                *(LAS u32x4*)(Vl + rr * VP + c * 16) = vv;
            }
        }
        bf16x8 qf[4];
        {
            float ss = 0.f;
#pragma unroll
            for (int ks = 0; ks < 4; ++ks) {
                const float a0 = bflo(qraw[ks].x), a1 = bfhi(qraw[ks].x), a2 = bflo(qraw[ks].y), a3 = bfhi(qraw[ks].y), a4 = bflo(qraw[ks].z), a5 = bfhi(qraw[ks].z), a6 = bflo(qraw[ks].w), a7 = bfhi(qraw[ks].w);
                ss += (a0 * a0 + a1 * a1) + (a2 * a2 + a3 * a3) + (a4 * a4 + a5 * a5) + (a6 * a6 + a7 * a7); }
            ss += __shfl_xor(ss, 32);
            const float rs = rsqrtf(ss * (1.f / 64.f) + 1e-6f) * (0.125f * LOG2E);
#pragma unroll
            for (int ks = 0; ks < 4; ++ks) { const float* gp = q_gain + g * 64 + 16 * ks + 8 * hh;
                u32x4 o; o.x = cvt_pk_bf16(bflo(qraw[ks].x) * rs * gp[0], bfhi(qraw[ks].x) * rs * gp[1]); o.y = cvt_pk_bf16(bflo(qraw[ks].y) * rs * gp[2], bfhi(qraw[ks].y) * rs * gp[3]);
                o.z = cvt_pk_bf16(bflo(qraw[ks].z) * rs * gp[4], bfhi(qraw[ks].z) * rs * gp[5]); o.w = cvt_pk_bf16(bflo(qraw[ks].w) * rs * gp[6], bfhi(qraw[ks].w) * rs * gp[7]);
                qf[ks] = __builtin_bit_cast(bf16x8, o); }
        }
        { size_t zo_ = 0; asm volatile("" : "+v"(zo_)); const int un = ATT_UNIT(ui + 1); if (ui + 1 < nui && un < 1024) ATT_LOAD(un); }
        const int iq = i0 + 32 * wid + r32;
        const int t = iq * dil + cls;
        float* np = Nacc + (size_t)t * DM + head * 64;
        float* zp = Zacc + (size_t)t * 16 + head;
        f32x4 nold[8]; float zold = 0.f;
        if (g > 0) { zold = *zp;
#pragma unroll
            for (int i = 0; i < 8; ++i) nold[i] = *(const f32x4*)(np + 32 * (i >> 2) + 8 * (i & 3) + 4 * hh); }
        BAR_LDS();
        f32x16 o0 = zero16(), o1 = zero16(); float zsum = 0.f;
        unsigned zl = 0; asm volatile("" : "+v"(zl) :: "memory");
        const int trow = ((lane & 15) >> 2) + 4 * hh, tcol = 16 * ((lane >> 4) & 1) + 4 * (lane & 3);
#pragma unroll 1
        for (int kt = 0; kt < 5; ++kt) {
            const int kb = 32 * wid + 32 * kt;
            f32x16 s = zero16();
#pragma unroll
            for (int ks = 0; ks < 4; ++ks) { const bf16x8 kf = *(const LAS bf16x8*)(Kl + (kb + r32) * KP + (16 * ks + 8 * hh) * 2); s = mfma32(kf, qf[ks], s); }
            const int ikb = i0 - 128 + kb;
            float p[16];
            const float cl = slope2 * (float)(ikb + 4 * hh - iq) - M2;
            const bool need_mask = (kt == 0) || (kt == 4) || (ikb < 0);
            if (need_mask) {
#pragma unroll
                for (int r = 0; r < 16; ++r) { const int m = (r & 3) + 8 * (r >> 2) + 4 * hh; const int ik = ikb + m; const int j = iq - ik;
                    const bool valid = (j >= 0) && (j <= 128) && (ik >= 0);
                    const float lg = s[r] + (cl + slope2 * (float)((r & 3) + 8 * (r >> 2)));
                    p[r] = valid ? __builtin_amdgcn_exp2f(lg) : 0.f; zsum += p[r]; }
            } else {
#pragma unroll
                for (int r = 0; r < 16; ++r) { const float lg = s[r] + (cl + slope2 * (float)((r & 3) + 8 * (r >> 2)));
                    p[r] = __builtin_amdgcn_exp2f(lg); zsum += p[r]; }
            }
            u32x4 pa, pb;
            pa.x = cvt_pk_bf16(p[0], p[1]); pa.y = cvt_pk_bf16(p[2], p[3]); pa.z = cvt_pk_bf16(p[4], p[5]); pa.w = cvt_pk_bf16(p[6], p[7]);
            pb.x = cvt_pk_bf16(p[8], p[9]); pb.y = cvt_pk_bf16(p[10], p[11]); pb.z = cvt_pk_bf16(p[12], p[13]); pb.w = cvt_pk_bf16(p[14], p[15]);
            const bf16x8 pf0 = __builtin_bit_cast(bf16x8, pa), pf1 = __builtin_bit_cast(bf16x8, pb);
#pragma unroll
            for (int ksp = 0; ksp < 2; ++ksp) {
                const bf16x8 pf = ksp ? pf1 : pf0;
#pragma unroll
                for (int mt = 0; mt < 2; ++mt) {
                    LAS const unsigned char* a0 = Vl + zl + (kb + 16 * ksp + trow) * VP + (32 * mt + tcol) * 2;
                    const s16x4 lo = tr_read(a0), hi = tr_read(a0 + 8 * VP);
                    const bf16x8 vf = cat8(lo, hi);
                    if (mt == 0) o0 = mfma32(vf, pf, o0); else o1 = mfma32(vf, pf, o1);
                }
            }
        }
        asm volatile("" : "+v"(o0), "+v"(o1) :: "memory");
        zsum += __shfl_xor(zsum, 32);
        float zt = zsum;
        if (g > 0) zt += zold;
        if (g < 2) { if (hh == 0) *zp = zt; }
        const float zinv = __builtin_amdgcn_rcpf(zt);
#pragma unroll
        for (int mt = 0; mt < 2; ++mt)
#pragma unroll
            for (int rg = 0; rg < 4; ++rg) {
                const int dim = 32 * mt + 8 * rg + 4 * hh;
                f32x4 v;
#pragma unroll
                for (int e = 0; e < 4; ++e) v[e] = mt ? o1[4 * rg + e] : o0[4 * rg + e];
                if (g > 0) v = v + nold[mt * 4 + rg];
                if (g < 2) *(f32x4*)(np + dim) = v;
                else { u32x2 o; o.x = cvt_pk_bf16(v[0] * zinv, v[1] * zinv); o.y = cvt_pk_bf16(v[2] * zinv, v[3] * zinv); *(u32x2*)(obuf + (size_t)t * DM + head * 64 + dim) = o; }
            }
    }
}


constexpr size_t WS_CARRY = 12 * MiB;
constexpr size_t WS_XM = 26 * MiB;
constexpr size_t WS_XC = 43 * MiB;
constexpr size_t WS_QB = 59 * MiB;
constexpr size_t WS_KB = 75 * MiB;
constexpr size_t WS_VB = 91 * MiB;
constexpr size_t WS_ZG = 107 * MiB;
constexpr size_t WS_ST = 171 * MiB;
constexpr size_t WS_HSEG = 236 * MiB;
constexpr size_t MS_IPRE = 4096, MS_LOGF = 4096 + 262144, MS_NST = 1 * MiB, MS_MPREV = 2 * MiB, MS_MCARRY = 2 * MiB + 4096, MS_NCARRY = 3 * MiB;
constexpr int SEG = 4096, NSEG = 4, NCH = SEG / 128;
constexpr size_t MS_GFOLD = 3 * ((size_t)1 << 20) + 262144;
constexpr float KSCALE = 0.044194173824159216f;

__device__ __forceinline__ void unpack8(const u32x4 r, float* x) { x[0] = bflo(r.x); x[1] = bfhi(r.x); x[2] = bflo(r.y); x[3] = bfhi(r.y); x[4] = bflo(r.z); x[5] = bfhi(r.z); x[6] = bflo(r.w); x[7] = bfhi(r.w); }
__device__ __forceinline__ void load_w32(const float* w, float* W) {
#pragma unroll
    for (int i = 0; i < 8; ++i) { const f32x4 v = ((const f32x4*)w)[i]; W[4 * i] = v[0]; W[4 * i + 1] = v[1]; W[4 * i + 2] = v[2]; W[4 * i + 3] = v[3]; }
}
__device__ __forceinline__ u32x4 bd8(const u32x4 raw, const float* W, float scale) {
    float x[8]; unpack8(raw, x); float o[8];
#pragma unroll
    for (int b = 0; b < 2; ++b)
#pragma unroll
        for (int k = 0; k < 4; ++k) o[4 * b + k] = (x[4 * b] * W[16 * b + k] + x[4 * b + 1] * W[16 * b + 4 + k] + x[4 * b + 2] * W[16 * b + 8 + k] + x[4 * b + 3] * W[16 * b + 12 + k]) * scale;
    u32x4 r; r.x = cvt_pk_bf16(o[0], o[1]); r.y = cvt_pk_bf16(o[2], o[3]); r.z = cvt_pk_bf16(o[4], o[5]); r.w = cvt_pk_bf16(o[6], o[7]); return r;
}
__device__ __forceinline__ u32x4 bd8dot(const u32x4 raw, const float* W, float scale, const f32x4 na, const f32x4 nb, float& dot) {
    float x[8]; unpack8(raw, x); float o[8];
#pragma unroll
    for (int b = 0; b < 2; ++b)
#pragma unroll
        for (int k = 0; k < 4; ++k) o[4 * b + k] = (x[4 * b] * W[16 * b + k] + x[4 * b + 1] * W[16 * b + 4 + k] + x[4 * b + 2] * W[16 * b + 8 + k] + x[4 * b + 3] * W[16 * b + 12 + k]) * scale;
    dot += (o[0] * na[0] + o[1] * na[1]) + (o[2] * na[2] + o[3] * na[3]) + (o[4] * nb[0] + o[5] * nb[1]) + (o[6] * nb[2] + o[7] * nb[3]);
    u32x4 r; r.x = cvt_pk_bf16(o[0], o[1]); r.y = cvt_pk_bf16(o[2], o[3]); r.z = cvt_pk_bf16(o[4], o[5]); r.w = cvt_pk_bf16(o[6], o[7]); return r;
}
__device__ __forceinline__ float wave_scan_add(float v, int lane) {
#pragma unroll
    for (int o = 1; o < 64; o <<= 1) { const float n = __shfl_up(v, o); if (lane >= o) v += n; }
    return v;
}
__device__ __forceinline__ float wave_scan_max(float v, int lane) {
#pragma unroll
    for (int o = 1; o < 64; o <<= 1) { const float n = __shfl_up(v, o); if (lane >= o) v = fmaxf(v, n); }
    return v;
}

__device__ __forceinline__ void m2_fold(const int tid, const float* wq, const float* wk, const float* wv, const float* wgate, float* gfold) {
    const int c0 = 4 * tid;
    float Wq[16], Wk[16], Wv[16], Gc[4][8], Gvv[4][8];
#pragma unroll
    for (int i = 0; i < 4; ++i) { const f32x4 a = ((const f32x4*)(wq + tid * 16))[i], b = ((const f32x4*)(wk + tid * 16))[i], c = ((const f32x4*)(wv + tid * 16))[i];
#pragma unroll
        for (int e = 0; e < 4; ++e) { Wq[4 * i + e] = a[e]; Wk[4 * i + e] = b[e]; Wv[4 * i + e] = c[e]; } }
    {
    float Gq[4][8], Gk[4][8], Gv[4][8];
#pragma unroll
    for (int c = 0; c < 4; ++c)
#pragma unroll
        for (int h2 = 0; h2 < 2; ++h2) { const f32x4 a = *(const f32x4*)(wgate + (size_t)(c0 + c) * 8 + 4 * h2), b = *(const f32x4*)(wgate + (size_t)(BIN + c0 + c) * 8 + 4 * h2), d = *(const f32x4*)(wgate + (size_t)(2 * BIN + c0 + c) * 8 + 4 * h2);
#pragma unroll
            for (int e = 0; e < 4; ++e) { Gq[c][4 * h2 + e] = a[e]; Gk[c][4 * h2 + e] = b[e]; Gv[c][4 * h2 + e] = d[e]; } }
#pragma unroll
    for (int j = 0; j < 4; ++j)
#pragma unroll
        for (int gi = 0; gi < 8; ++gi) { float a = 0.f, b = 0.f;
#pragma unroll
            for (int k = 0; k < 4; ++k) { a += Wq[4 * j + k] * Gq[k][gi] + Wk[4 * j + k] * Gk[k][gi]; b += Wv[4 * j + k] * Gv[k][gi]; }
            Gc[j][gi] = a; Gvv[j][gi] = b; }
    }
#pragma unroll
    for (int j = 0; j < 4; ++j)
#pragma unroll
        for (int gi = 0; gi < 8; ++gi) { gfold[(size_t)(j * 8 + gi) * 512 + tid] = Gc[j][gi]; gfold[(size_t)(32 + j * 8 + gi) * 512 + tid] = Gvv[j][gi]; }
}

__device__ __forceinline__ void m2_phase(LAS unsigned char* lds, const int tid, const int bx, const int G, const int seg, const bf16_t* xm, bf16_t* xc, bf16_t* qo, bf16_t* ko, bf16_t* vo, float* ipre, float* logf,
                                         const float* conv_w, const float* conv_b, const float* wq, const float* wk, const float* wv, const float* gfold, const float* bgate) {
    const int lane = tid & 63, wid = tid >> 6, c0 = 4 * tid;
#define M2_STAGE(T0) do { LAS unsigned char* xs = lds + 8192; __syncthreads(); \
        _Pragma("unroll") for (int hb = 0; hb < 2; ++hb) { u32x4 rr[5]; \
        _Pragma("unroll") for (int i = 0; i < 5; ++i) { const int e = tid + 512 * (5 * hb + i); const int row = e >> 8, cq = e & 255; if (row < 19) rr[i] = *(const u32x4*)(xm + (size_t)((T0) + row) * BIN + 8 * cq); } \
        _Pragma("unroll") for (int i = 0; i < 5; ++i) { const int e = tid + 512 * (5 * hb + i); const int row = e >> 8, cq = e & 255; if (row < 19) *(LAS u32x4*)(xs + row * 4096 + cq * 16) = rr[i]; } } \
        __syncthreads(); } while (0)
    if (bx < SEG / 16) { M2_STAGE(bx * 16); }
    float cw[4][4], cb[4], Wq[16], Wk[16], Wv[16], Gc[4][8], Gvv[4][8];
#pragma unroll
    for (int k = 0; k < 4; ++k) { const f32x4 v = *(const f32x4*)(conv_w + k * BIN + c0); cw[k][0] = v[0]; cw[k][1] = v[1]; cw[k][2] = v[2]; cw[k][3] = v[3]; }
    { const f32x4 v = *(const f32x4*)(conv_b + c0); cb[0] = v[0]; cb[1] = v[1]; cb[2] = v[2]; cb[3] = v[3]; }
#pragma unroll
    for (int i = 0; i < 4; ++i) { const f32x4 a = ((const f32x4*)(wq + tid * 16))[i], b = ((const f32x4*)(wk + tid * 16))[i], c = ((const f32x4*)(wv + tid * 16))[i];
#pragma unroll
        for (int e = 0; e < 4; ++e) { Wq[4 * i + e] = a[e]; Wk[4 * i + e] = b[e]; Wv[4 * i + e] = c[e]; } }
#pragma unroll
    for (int j = 0; j < 4; ++j)
#pragma unroll
        for (int gi = 0; gi < 8; ++gi) { Gc[j][gi] = gfold[(size_t)(j * 8 + gi) * 512 + tid]; Gvv[j][gi] = gfold[(size_t)(32 + j * 8 + gi) * 512 + tid]; }
    LAS float* part = (LAS float*)lds;
    const int b0 = lane & 1, b1 = (lane >> 1) & 1, b2 = (lane >> 2) & 1, b3 = (lane >> 3) & 1, gidx4 = 8 * b0 + 4 * b1 + 2 * b2 + b3;
    for (int u = bx; u < SEG / 16; u += G) {
        const int t0 = u * 16;
        if (u != bx) { M2_STAGE(u * 16); }
        LAS const unsigned char* xrow = lds + 8192 + c0 * 2;
#pragma unroll 1
        for (int tb = 0; tb < 16; tb += 2) {
            float gp[16];
#pragma unroll
            for (int j4 = 0; j4 < 2; ++j4) {
            const int tt = tb + j4;
            float x0[4], x1[4], x2[4], x3[4];
            { const u32x2 r0 = *(const LAS u32x2*)(xrow + tt * 4096), r1 = *(const LAS u32x2*)(xrow + (tt + 1) * 4096), r2 = *(const LAS u32x2*)(xrow + (tt + 2) * 4096), r3 = *(const LAS u32x2*)(xrow + (tt + 3) * 4096);
              x0[0] = bflo(r0.x); x0[1] = bfhi(r0.x); x0[2] = bflo(r0.y); x0[3] = bfhi(r0.y);
              x1[0] = bflo(r1.x); x1[1] = bfhi(r1.x); x1[2] = bflo(r1.y); x1[3] = bfhi(r1.y);
              x2[0] = bflo(r2.x); x2[1] = bfhi(r2.x); x2[2] = bflo(r2.y); x2[3] = bfhi(r2.y);
              x3[0] = bflo(r3.x); x3[1] = bfhi(r3.x); x3[2] = bflo(r3.y); x3[3] = bfhi(r3.y); }
            float xv[4];
#pragma unroll
            for (int c = 0; c < 4; ++c) { const float y = cb[c] + cw[0][c] * x0[c] + cw[1][c] * x1[c] + cw[2][c] * x2[c] + cw[3][c] * x3[c]; xv[c] = y * __builtin_amdgcn_rcpf(1.f + __expf(-y)); }
            { u32x2 o; o.x = cvt_pk_bf16(xv[0], xv[1]); o.y = cvt_pk_bf16(xv[2], xv[3]); *(u32x2*)(xc + (size_t)(t0 + tt) * BIN + c0) = o; }
            float q[4], kk[4], vv[4];
#pragma unroll
            for (int k = 0; k < 4; ++k) { q[k] = xv[0] * Wq[k] + xv[1] * Wq[4 + k] + xv[2] * Wq[8 + k] + xv[3] * Wq[12 + k];
                kk[k] = xv[0] * Wk[k] + xv[1] * Wk[4 + k] + xv[2] * Wk[8 + k] + xv[3] * Wk[12 + k];
                vv[k] = x3[0] * Wv[k] + x3[1] * Wv[4 + k] + x3[2] * Wv[8 + k] + x3[3] * Wv[12 + k]; }
            { const size_t o = (size_t)(t0 + tt) * BIN + c0; u32x2 w;
              w.x = cvt_pk_bf16(q[0], q[1]); w.y = cvt_pk_bf16(q[2], q[3]); *(u32x2*)(qo + o) = w;
              w.x = cvt_pk_bf16(kk[0] * KSCALE, kk[1] * KSCALE); w.y = cvt_pk_bf16(kk[2] * KSCALE, kk[3] * KSCALE); *(u32x2*)(ko + o) = w;
              w.x = cvt_pk_bf16(vv[0], vv[1]); w.y = cvt_pk_bf16(vv[2], vv[3]); *(u32x2*)(vo + o) = w; }
#pragma unroll
            for (int gi = 0; gi < 8; ++gi) { float a = 0.f;
#pragma unroll
                for (int c = 0; c < 4; ++c) a += xv[c] * Gc[c][gi] + x3[c] * Gvv[c][gi];
                gp[j4 * 8 + gi] = a; }
            }
            float h8[8], h4[4], h2[2], a1;
#pragma unroll
            for (int i = 0; i < 8; ++i) { const float send = b0 ? gp[i] : gp[8 + i]; const float recv = __shfl_xor(send, 1); h8[i] = (b0 ? gp[8 + i] : gp[i]) + recv; }
#pragma unroll
            for (int i = 0; i < 4; ++i) { const float send = b1 ? h8[i] : h8[4 + i]; const float recv = __shfl_xor(send, 2); h4[i] = (b1 ? h8[4 + i] : h8[i]) + recv; }
#pragma unroll
            for (int i = 0; i < 2; ++i) { const float send = b2 ? h4[i] : h4[2 + i]; const float recv = __shfl_xor(send, 4); h2[i] = (b2 ? h4[2 + i] : h4[i]) + recv; }
            { const float send = b3 ? h2[0] : h2[1]; const float recv = __shfl_xor(send, 8); a1 = (b3 ? h2[1] : h2[0]) + recv; }
            a1 += __shfl_xor(a1, 16); a1 += __shfl_xor(a1, 32);
            if (lane < 16) part[((tb + (gidx4 >> 3)) * 8 + wid) * 8 + (gidx4 & 7)] = a1;
        }
        __syncthreads();
        if (tid < 128) { const int tok = tid >> 3, gi = tid & 7; float v = bgate[gi];
#pragma unroll
            for (int w = 0; w < 8; ++w) v += part[(tok * 8 + w) * 8 + gi];
            const size_t tg = (size_t)seg * SEG + t0 + tok;
            if (gi < 4) ipre[tg * 4 + gi] = v; else logf[tg * 4 + gi - 4] = fminf(v, 0.f) - log1pf(__expf(-fabsf(v))); }
        __syncthreads();
    }
}

__device__ __forceinline__ u32x4 scale8(const u32x4 r, float w) {
    u32x4 o; o.x = cvt_pk_bf16(bflo(r.x) * w, bfhi(r.x) * w); o.y = cvt_pk_bf16(bflo(r.y) * w, bfhi(r.y) * w);
    o.z = cvt_pk_bf16(bflo(r.z) * w, bfhi(r.z) * w); o.w = cvt_pk_bf16(bflo(r.w) * w, bfhi(r.w) * w); return o;
}
__device__ __forceinline__ void m3_phase(LAS unsigned char* lds, const int tid_, const int bx, const int G, const int seg, const bf16_t* kb, const bf16_t* vb, const float* ipre, const float* logf,
                                         bf16_t* states, float* nstates, float* mprev_g, float* mcarry, float* carryC, float* ncarry) {
    constexpr int KP = 144;
    LAS float* a_s = (LAS float*)lds;
    LAS float* bl = (LAS float*)(lds + 32768); LAS float* am = bl + 64; LAS float* Al = bl + 128; LAS float* dec = bl + 192;
    LAS unsigned char* Kt = lds + 36864;
    for (int u = bx; u < 256; u += G) {
        int tid = tid_; asm volatile("" : "+v"(tid));
        const int lane = tid & 63, wid = __builtin_amdgcn_readfirstlane(tid >> 6), r32 = lane & 31, hh = lane >> 5;
        const int xcd = u & 7, idx = u >> 3;
        const int head = xcd >> 1, dt = (xcd & 1) * 4 + (idx >> 3), et = idx & 7;
        __syncthreads();
        for (int c = wid; c < NCH; c += 8) {
            const size_t tg = (size_t)seg * SEG + c * 128 + 2 * lane;
            const float lf0 = logf[tg * 4 + head], lf1 = logf[(tg + 1) * 4 + head], i0 = ipre[tg * 4 + head], i1 = ipre[(tg + 1) * 4 + head];
            const float ps = lf0 + lf1; const float incl = wave_scan_add(ps, lane);
            const float bb0 = incl - lf1, bb1 = incl; const float a0 = i0 - bb0, a1 = i1 - bb1;
            const float amax = wave_max(fmaxf(a0, a1)); const float blast = __shfl(incl, 63);
            a_s[c * 128 + 2 * lane] = a0; a_s[c * 128 + 2 * lane + 1] = a1;
            if (lane == 0) { bl[c] = blast; am[c] = amax; }
        }
        __syncthreads();
        if (wid == 0) {
            const float amr = (lane < NCH) ? am[lane] : 0.f, blr = (lane < NCH) ? bl[lane] : 0.f;
            float m = (seg == 0) ? -1e30f : mcarry[4 * seg + head];
            m = __int_as_float(__builtin_amdgcn_readfirstlane(__float_as_int(m)));
            float myA = 0.f, myd = 0.f, mym = 0.f;
#pragma unroll
            for (int c = 0; c < NCH; ++c) { const float amc = __int_as_float(__builtin_amdgcn_readlane(__float_as_int(amr), c)), blc = __int_as_float(__builtin_amdgcn_readlane(__float_as_int(blr), c));
                const float A = fmaxf(m, amc); const float d = __expf(m - A);
                if (lane == c) { myA = A; myd = d; mym = m; }
                m = blc + A; }
            if (lane < NCH) { Al[lane] = myA; dec[lane] = myd; if (dt == 0 && et == 0) mprev_g[(seg * NCH + lane) * 4 + head] = mym; }
            if (lane == 0 && dt == 0 && et == 0 && seg + 1 < NSEG) mcarry[4 * (seg + 1) + head] = m;
        }
        __syncthreads();
        const int cc = tid & 7, rowp = tid >> 3;
        const int kch = head * 512 + dt * 64 + 8 * cc, vch = head * 512 + et * 64 + 8 * cc;
        const int mt = wid & 1, nt = (wid >> 1) & 1; const bool do_n = (et == 0) && (wid < 2);
        f32x16 accC = zero16(), nacc = zero16();
        const int dbase = dt * 64 + 32 * mt + 4 * hh, ecol = et * 64 + 32 * nt + r32;
        if (seg > 0 && wid < 4) {
#pragma unroll
            for (int r = 0; r < 16; ++r) { const int d = dbase + (r & 3) + 8 * (r >> 2); accC[r] = carryC[((size_t)head * 512 + d) * 512 + ecol]; if (do_n) nacc[r] = ncarry[head * 512 + d]; }
        }
        bf16x8 ones;
#pragma unroll
        for (int i = 0; i < 8; ++i) ones[i] = (short)0x3F80;
        const int q4 = (lane & 15) >> 2, tcol = 16 * ((lane >> 4) & 1) + 4 * (lane & 3);
        LAS unsigned char* Sn = lds + 110592;
        if (wid < 4) {
#pragma unroll
            for (int r = 0; r < 16; ++r) { const int dl = 32 * mt + 4 * hh + (r & 3) + 8 * (r >> 2);
                *(LAS unsigned short*)(Sn + dl * KP + (32 * nt + r32) * 2) = (unsigned short)(cvt_pk_bf16(accC[r], 0.f) & 0xffffu); }
        }
        const bf16_t* xk0 = kb + (size_t)rowp * BIN + kch; const bf16_t* xv0 = vb + (size_t)rowp * BIN + vch;
        u32x4 pk[4][2], pv[4][2];
#pragma unroll
        for (int j = 0; j < 4; ++j)
#pragma unroll
            for (int hf = 0; hf < 2; ++hf) { pk[j][hf] = *(const u32x4*)(xk0 + (size_t)(128 * j + 64 * hf) * BIN); pv[j][hf] = *(const u32x4*)(xv0 + (size_t)(128 * j + 64 * hf) * BIN); }
#pragma unroll 1
        for (int c4 = 0; c4 < NCH; c4 += 4) {
#pragma unroll
          for (int j = 0; j < 4; ++j) {
            const int c = c4 + j;
            size_t zo = 0; asm volatile("" : "+v"(zo));
            LAS unsigned char* Kb = Kt + (c & 1) * (256 * KP); LAS unsigned char* Vb = Kb + 128 * KP;
            const float Ac = Al[c];
#pragma unroll
            for (int hf = 0; hf < 2; ++hf) { const int row = rowp + 64 * hf;
                const float wsc = __expf(a_s[c * 128 + row] - Ac);
                *(LAS u32x4*)(Kb + row * KP + cc * 16) = scale8(pk[j][hf], wsc);
                *(LAS u32x4*)(Vb + row * KP + cc * 16) = pv[j][hf]; }
            const int cn = (c + 4 < NCH) ? c + 4 : NCH - 1;
#pragma unroll
            for (int hf = 0; hf < 2; ++hf) {
                pk[j][hf] = *(const u32x4*)(xk0 + zo + (size_t)(cn * 128 + 64 * hf) * BIN); pv[j][hf] = *(const u32x4*)(xv0 + zo + (size_t)(cn * 128 + 64 * hf) * BIN); }
            BAR_LDS();
            {   const u32x4 sv = *(const LAS u32x4*)(Sn + (c & 1) * (64 * KP) + rowp * KP + cc * 16);
                *(u32x4*)(states + zo + ((size_t)(c * 4 + head) * 512 + dt * 64 + rowp) * 512 + et * 64 + cc * 8) = sv; }
            if (wid < 4) {
                if (do_n && r32 == 0) {
#pragma unroll
                    for (int r = 0; r < 16; ++r) { const int d = dbase + (r & 3) + 8 * (r >> 2); nstates[(size_t)(c * 4 + head) * 512 + d] = nacc[r]; } }
                unsigned zl = 0; asm volatile("" : "+v"(zl) :: "memory");
                const float dc = dec[c];
#pragma unroll
                for (int r = 0; r < 16; ++r) { accC[r] *= dc; nacc[r] *= dc; }
#pragma unroll
                for (int ks = 0; ks < 8; ++ks) {
                    LAS const unsigned char* ka = Kb + zl + (16 * ks + 8 * hh + q4) * KP + (32 * mt + tcol) * 2;
                    LAS const unsigned char* va = Vb + zl + (16 * ks + 8 * hh + q4) * KP + (32 * nt + tcol) * 2;
                    const bf16x8 af = cat8(tr_read(ka), tr_read(ka + 4 * KP));
                    const bf16x8 bf = cat8(tr_read(va), tr_read(va + 4 * KP));
                    accC = mfma32(af, bf, accC);
                    nacc = mfma32(af, ones, nacc);
                }
                asm volatile("" : "+v"(accC), "+v"(nacc) :: "memory");
                LAS unsigned char* Sw = Sn + ((c + 1) & 1) * (64 * KP);
#pragma unroll
                for (int r = 0; r < 16; ++r) { const int dl = 32 * mt + 4 * hh + (r & 3) + 8 * (r >> 2);
                    *(LAS unsigned short*)(Sw + dl * KP + (32 * nt + r32) * 2) = (unsigned short)(cvt_pk_bf16(accC[r], 0.f) & 0xffffu); }
            }
          }
        }
        if (seg + 1 < NSEG && wid < 4) {
#pragma unroll
            for (int r = 0; r < 16; ++r) { const int d = dbase + (r & 3) + 8 * (r >> 2); carryC[((size_t)head * 512 + d) * 512 + ecol] = accC[r]; if (do_n && r32 == 0) ncarry[head * 512 + d] = nacc[r]; }
        }
    }
}

__device__ __forceinline__ void m4_phase(LAS unsigned char* lds, const int tid_, const int bx, const int G, const int seg, const bf16_t* qb, const bf16_t* kb, const bf16_t* vb, const bf16_t* __restrict__ xc, bf16_t* __restrict__ zg,
                                         const float* ipre, const float* logf, const bf16_t* states, const float* nstates, const float* mprev_g, const float* hgain, const float* skip) {
    constexpr int KP = 144, PP = 272, BP = 1088;
    LAS float* sa = (LAS float*)lds; LAS float* sA = sa + 128; LAS float* smt = sa + 256; LAS float* ssc = sa + 384; LAS float* sden = sa + 512; LAS float* sssq = sa + 640; LAS float* sdenp = sa + 1152;
    LAS unsigned char* PL = lds + 8192; LAS unsigned char* QS = lds + 43008; LAS unsigned char* KS = lds + 61440; LAS unsigned char* BT = lds + 61440;
    for (int u = bx; u < NCH * 8; u += G) {
        int tid = tid_; asm volatile("" : "+v"(tid));
        const int lane = tid & 63, wid = __builtin_amdgcn_readfirstlane(tid >> 6), r32 = lane & 31, hh = lane >> 5;
        const int q4 = (lane & 15) >> 2, tcol = 16 * ((lane >> 4) & 1) + 4 * (lane & 3);
        const bool xmap = (G == 256 && NCH * 8 == 256);
        const int xq = u & 7, jq = u >> 3, pairidx = xq * 16 + (jq >> 1);
        const int half = xmap ? (jq & 1) : (u & 1), c = xmap ? (pairidx >> 2) : (u >> 3), head = xmap ? (pairidx & 3) : ((u >> 1) & 3);
        const size_t rbase = (size_t)c * 128;
        __syncthreads();
        if (wid == 0) {
            const size_t tg = (size_t)seg * SEG + c * 128 + 2 * lane;
            const float lf0 = logf[tg * 4 + head], lf1 = logf[(tg + 1) * 4 + head], i0 = ipre[tg * 4 + head], i1 = ipre[(tg + 1) * 4 + head];
            const float incl = wave_scan_add(lf0 + lf1, lane);
            const float bb0 = incl - lf1, bb1 = incl; const float a0 = i0 - bb0, a1 = i1 - bb1;
            const float mp = mprev_g[(seg * NCH + c) * 4 + head];
            const float inclm = wave_scan_max(fmaxf(a0, a1), lane); float exclm = __shfl_up(inclm, 1); if (lane == 0) exclm = -3e38f;
            const float A0 = fmaxf(mp, fmaxf(exclm, a0)), A1 = fmaxf(mp, inclm);
            sa[2 * lane] = a0; sa[2 * lane + 1] = a1; sA[2 * lane] = A0; sA[2 * lane + 1] = A1; smt[2 * lane] = bb0 + A0; smt[2 * lane + 1] = bb1 + A1;
            ssc[2 * lane] = __expf(mp - A0); ssc[2 * lane + 1] = __expf(mp - A1);
            sdenp[2 * lane] = 0.f; sdenp[2 * lane + 1] = 0.f;
        }
        __syncthreads();
        const int cc = tid & 7, rowp = tid >> 3;
        const int trow = 64 * half + rowp;
        const int chh = head * 512 + 8 * cc;
        {
            const int st = wid & 3, tt = 2 * half + (wid >> 2);
            f32x16 s0 = zero16();
            u32x4 rq = *(const u32x4*)(qb + (rbase + trow) * BIN + chh), rk0 = *(const u32x4*)(kb + (rbase + rowp) * BIN + chh), rk1 = *(const u32x4*)(kb + (rbase + rowp + 64) * BIN + chh);
#pragma unroll 1
            for (int ds_ = 0; ds_ < 8; ++ds_) {
                int ds = ds_; asm volatile("" : "+s"(ds));
                size_t zo = 0; asm volatile("" : "+v"(zo));
                *(LAS u32x4*)(QS + rowp * KP + cc * 16) = rq;
                *(LAS u32x4*)(KS + rowp * KP + cc * 16) = rk0;
                *(LAS u32x4*)(KS + (rowp + 64) * KP + cc * 16) = rk1;
                { const int dn = (ds + 1 < 8) ? ds + 1 : 7;
                  rq = *(const u32x4*)(qb + zo + (rbase + trow) * BIN + chh + dn * 64);
                  rk0 = *(const u32x4*)(kb + zo + (rbase + rowp) * BIN + chh + dn * 64);
                  rk1 = *(const u32x4*)(kb + zo + (rbase + rowp + 64) * BIN + chh + dn * 64); }
                BAR_LDS();
#pragma unroll
                for (int ks = 0; ks < 4; ++ks) { const bf16x8 kf = *(const LAS bf16x8*)(KS + (32 * st + r32) * KP + (16 * ks + 8 * hh) * 2);
                    const bf16x8 q0 = *(const LAS bf16x8*)(QS + (32 * (wid >> 2) + r32) * KP + (16 * ks + 8 * hh) * 2);
                    s0 = mfma32(kf, q0, s0); }
                BAR_LDS();
            }
            { const int t = 32 * tt + r32; const float At = sA[t]; float psum = 0.f;
#pragma unroll
                for (int rg = 0; rg < 4; ++rg) { float p[4];
#pragma unroll
                    for (int e = 0; e < 4; ++e) { const int sidx = 32 * st + 8 * rg + 4 * hh + e; const float sv = s0[4 * rg + e];
                        p[e] = (sidx <= t) ? sv * __expf(sa[sidx] - At) : 0.f; psum += p[e]; }
                    u32x2 o; o.x = cvt_pk_bf16(p[0], p[1]); o.y = cvt_pk_bf16(p[2], p[3]);
                    *(LAS u32x2*)(PL + t * PP + (32 * st + 8 * rg + 4 * hh) * 2) = o; }
                psum += __shfl_xor(psum, 32);
                if (hh == 0) atomicAdd((float*)(sdenp + t), psum);
            }
        }
        {
            const int mt = (wid & 1) + 2 * half, nt0 = wid >> 1;
            f32x16 acc[4];
#pragma unroll
            for (int i = 0; i < 4; ++i) acc[i] = zero16();
            float dq0 = 0.f;
            u32x4 btA[8], btB[8], rqA = (u32x4){0u, 0u, 0u, 0u}, rqB = rqA; f32x4 naA = (f32x4){0.f, 0.f, 0.f, 0.f}, nbA = naA, naB = naA, nbB = naA;
#define M4_LOAD(SL, BT_, RQ_, NA_, NB_) do { size_t zo_ = 0; asm volatile("" : "+v"(zo_)); const bf16_t* src_; \
                if ((SL) < 8) { const float* np8 = nstates + zo_ + (size_t)(c * 4 + head) * 512 + (SL) * 64 + 8 * cc; NA_ = *(const f32x4*)np8; NB_ = *(const f32x4*)(np8 + 4); \
                    RQ_ = *(const u32x4*)(qb + zo_ + (rbase + trow) * BIN + chh + (SL) * 64); \
                    src_ = states + zo_ + (((size_t)(c * 4 + head) * 512) + (SL) * 64 + rowp) * 512; } \
                else src_ = vb + zo_ + (rbase + ((SL) - 8) * 64 + rowp) * BIN + head * 512; \
                _Pragma("unroll") for (int i_ = 0; i_ < 8; ++i_) BT_[i_] = *(const u32x4*)(src_ + 8 * (cc + 8 * i_)); } while (0)
#define M4_ROUND(SL, BT_, RQ_, NA_, NB_) do { \
                BAR_LDS(); \
                if ((SL) < 8) { const float sc = ssc[trow]; float x[8]; unpack8(RQ_, x); \
                    _Pragma("unroll") for (int j = 0; j < 8; ++j) x[j] *= sc; \
                    dq0 += (x[0] * NA_[0] + x[1] * NA_[1]) + (x[2] * NA_[2] + x[3] * NA_[3]) + (x[4] * NB_[0] + x[5] * NB_[1]) + (x[6] * NB_[2] + x[7] * NB_[3]); \
                    u32x4 o; o.x = cvt_pk_bf16(x[0], x[1]); o.y = cvt_pk_bf16(x[2], x[3]); o.z = cvt_pk_bf16(x[4], x[5]); o.w = cvt_pk_bf16(x[6], x[7]); \
                    *(LAS u32x4*)(QS + rowp * KP + cc * 16) = o; } \
                _Pragma("unroll") for (int i = 0; i < 8; ++i) *(LAS u32x4*)(BT + rowp * BP + (cc + 8 * i) * 16) = BT_[i]; \
                if ((SL) + 2 < 10) M4_LOAD((SL) + 2, BT_, RQ_, NA_, NB_); \
                BAR_LDS(); \
                unsigned zl = 0; asm volatile("" : "+v"(zl) :: "memory"); \
                LAS const unsigned char* abase = (((SL) < 8) ? (QS + (32 * (wid & 1) + r32) * KP + 16 * hh) : (PL + (32 * mt + r32) * PP + (64 * ((SL) - 8) + 8 * hh) * 2)) + zl; \
                _Pragma("unroll") for (int ks = 0; ks < 4; ++ks) { \
                    const bf16x8 af = *(const LAS bf16x8*)(abase + 32 * ks); \
                    LAS const unsigned char* b0p = BT + zl + (16 * ks + 8 * hh + q4) * BP + tcol * 2; \
                    _Pragma("unroll") for (int i = 0; i < 4; ++i) { LAS const unsigned char* bp = b0p + (32 * (nt0 + 4 * i)) * 2; \
                        const bf16x8 bf = cat8(tr_read(bp), tr_read(bp + 4 * BP)); acc[i] = mfma32(af, bf, acc[i]); } } \
                asm volatile("" : "+v"(acc[0]), "+v"(acc[1]), "+v"(acc[2]), "+v"(acc[3]) :: "memory"); } while (0)
            M4_LOAD(0, btA, rqA, naA, nbA);
            M4_LOAD(1, btB, rqB, naB, nbB);
#pragma unroll 1
            for (int sl_ = 0; sl_ < 10; sl_ += 2) {
                int sl = sl_; asm volatile("" : "+s"(sl));
                M4_ROUND(sl, btA, rqA, naA, nbA);
                M4_ROUND(sl + 1, btB, rqB, naB, nbB);
            }
            dq0 += __shfl_xor(dq0, 1); dq0 += __shfl_xor(dq0, 2); dq0 += __shfl_xor(dq0, 4);
            if (cc == 0) sden[trow] = dq0;
            BAR_LDS();
#pragma unroll
            for (int r = 0; r < 16; ++r) { const int t = 32 * mt + (r & 3) + 8 * (r >> 2) + 4 * hh;
                const float dn = fmaxf(fabsf(sden[t] + sdenp[t]), __expf(-smt[t])); const float inv = __builtin_amdgcn_rcpf(dn); float q = 0.f;
#pragma unroll
                for (int i = 0; i < 4; ++i) { acc[i][r] *= inv; q += acc[i][r] * acc[i][r]; }
                q += __shfl_xor(q, 1); q += __shfl_xor(q, 2); q += __shfl_xor(q, 4); q += __shfl_xor(q, 8); q += __shfl_xor(q, 16);
                if (r32 == 0) sssq[nt0 * 128 + t] = q; }
            BAR_LDS();
#pragma unroll
            for (int i = 0; i < 4; ++i) { const int e = 32 * (nt0 + 4 * i) + r32; const int ch = head * 512 + e; const float hgv = hgain[ch], skv = skip[ch];
#pragma unroll
                for (int r = 0; r < 16; ++r) { const int t = 32 * mt + (r & 3) + 8 * (r >> 2) + 4 * hh;
                    const float rstd = rsqrtf(((sssq[t] + sssq[128 + t]) + (sssq[256 + t] + sssq[384 + t])) * (1.f / 512.f) + 1e-6f);
                    const size_t ro = (rbase + t) * BIN + ch;
                    const size_t rz = ((size_t)seg * SEG + rbase + t) * BIN + ch;
                    const float xcv = bf2f(xc[ro]), zv = bf2f(zg[rz]);
                    const float o = (acc[i][r] * rstd * hgv + skv * xcv) * (zv * __builtin_amdgcn_rcpf(1.f + __expf(-zv)));
                    zg[rz] = (bf16_t)(cvt_pk_bf16(o, 0.f) & 0xffffu); }
            }
        }
    }
}

#define XB_TMO      128
#define XB_XCNT(j)  (256  + 64 * (j))
#define XB_XSUB(j)  (1280 + 64 * (j))
#define XB_XGEN(j)  (2304 + 64 * (j))
#define XB_TOP      3328
#define XB_TOPGEN   3392
#define XCD_BAR_WORDS 3456
#define XB_SPIN_CAP (1u << 22)
__device__ __forceinline__ unsigned xb_ld(unsigned* p)              { return __hip_atomic_load(p, __ATOMIC_RELAXED, __HIP_MEMORY_SCOPE_AGENT); }
__device__ __forceinline__ unsigned xb_add(unsigned* p, unsigned v) { return __hip_atomic_fetch_add(p, v, __ATOMIC_RELAXED, __HIP_MEMORY_SCOPE_AGENT); }
__device__ __forceinline__ unsigned xb_xcc_id() { return (unsigned)__builtin_amdgcn_s_getreg((3 << 11) | 20) & 0xFu; }
#define XB_SPIN(cond, bar) do { unsigned _sp = 0; while (cond) { __builtin_amdgcn_s_sleep(1); \
    if ((++_sp & 255u) == 0u) { if (xb_ld(&(bar)[XB_TMO])) break; if (_sp > XB_SPIN_CAP) { atomicAdd(&(bar)[XB_TMO], 1u); break; } } } } while (0)
struct XcdBarrier { unsigned* bar; unsigned x; volatile LAS unsigned* st; };
__device__ __forceinline__ XcdBarrier xcd_barrier_post(unsigned* bar, volatile LAS unsigned* st) {
    XcdBarrier b; b.bar = bar; b.x = xb_xcc_id(); b.st = st;
    if (threadIdx.x == 0) (void)xb_add(&bar[XB_XCNT(b.x)], 1u);
    return b;
}
__device__ __forceinline__ void xcd_barrier_complete(unsigned* bar, unsigned x, unsigned& nloc, unsigned& nx) {
    const unsigned G = gridDim.x * gridDim.y * gridDim.z;
    unsigned sum, cnt, mine, sp = 0u;
    for (;;) {
        sum = 0u; cnt = 0u; mine = 0u;
#pragma unroll
        for (unsigned j = 0; j < 16; ++j) { const unsigned c = xb_ld(&bar[XB_XCNT(j)]); sum += c; cnt += (c > 0u) ? 1u : 0u; mine = (j == x) ? c : mine; }
        if (sum == G) break;
        __builtin_amdgcn_s_sleep(1);
        if ((++sp & 255u) == 0u) { if (xb_ld(&bar[XB_TMO])) break; if (sp > XB_SPIN_CAP) { atomicAdd(&bar[XB_TMO], 1u); break; } }
    }
    nloc = mine > 0u ? mine : 1u; nx = cnt > 0u ? cnt : 1u;
}
__device__ __forceinline__ void xcd_barrier(const XcdBarrier& b) {
    asm volatile("s_waitcnt vmcnt(0)" ::: "memory");
    __syncthreads();
    if (threadIdx.x == 0) {
        unsigned* bar = b.bar;
        __builtin_amdgcn_s_waitcnt(0);
        unsigned nloc = b.st[0], nx = b.st[1];
        if (nloc == 0u) { xcd_barrier_complete(bar, b.x, nloc, nx); b.st[0] = nloc; b.st[1] = nx; }
        const unsigned old = xb_add(&bar[XB_XSUB(b.x)], 1u);
        const unsigned gen = old / nloc;
        if (old + 1u == (gen + 1u) * nloc) {
            __builtin_amdgcn_fence(__ATOMIC_RELEASE, "agent");
            asm volatile("s_waitcnt vmcnt(0)" ::: "memory");
            const unsigned og = xb_add(&bar[XB_TOP], 1u);
            const unsigned tg = og / nx;
            if (og + 1u == (tg + 1u) * nx) xb_add(&bar[XB_TOPGEN], 1u);
            else XB_SPIN(xb_ld(&bar[XB_TOPGEN]) == tg, bar);
            __builtin_amdgcn_fence(__ATOMIC_ACQUIRE, "agent");
            xb_add(&bar[XB_XGEN(b.x)], 1u);
            asm volatile("s_waitcnt vmcnt(0)" ::: "memory");
        } else {
            XB_SPIN(xb_ld(&bar[XB_XGEN(b.x)]) == gen, bar);
            __builtin_amdgcn_fence(__ATOMIC_ACQUIRE, "agent");
            asm volatile("s_waitcnt vmcnt(0)" ::: "memory");
        }
    }
    __syncthreads();
}
constexpr size_t MS_BAR = 3 * ((size_t)1 << 20) + 65536;

__global__ void __launch_bounds__(512, 2) mega(Params P) {
    extern __shared__ __attribute__((aligned(16))) unsigned char lds_raw[];
    LAS unsigned char* lds = (LAS unsigned char*)lds_raw;
    cg::grid_group grid = cg::this_grid();
    const int G_ = gridDim.x, bx_ = blockIdx.x;
    unsigned char* ws_ = P.ws;
    float* xres_ = P.out;
    int ph = 0;
    XcdBarrier xbar; xbar.bar = nullptr; xbar.x = 0; xbar.st = nullptr;
    if (threadIdx.x < 2) ((volatile LAS unsigned*)(lds + 131072 + 64))[threadIdx.x] = 0u;
    __syncthreads();
#if !MULTI_LAUNCH
    xbar = xcd_barrier_post((unsigned*)(ws_ + WS_MISC + MS_BAR), (volatile LAS unsigned*)(lds + 131072 + 64));
#endif
#if MULTI_LAUNCH
#define OPAQUE unsigned char* ws = ws_; float* xres = xres_; int tid = threadIdx.x; int bx = bx_, G = G_; size_t zopq = 0; asm volatile("" : "+s"(zopq), "+v"(tid), "+s"(bx), "+s"(G)); ws += zopq; xres += zopq; float* misc = (float*)(ws + WS_MISC); \
    const int lane = tid & 63, wid = __builtin_amdgcn_readfirstlane(tid >> 6); const int gw = bx * 8 + wid, NGW = G * 8; const size_t gt = (size_t)bx * 512 + tid, ngt = (size_t)G * 512; \
    LAS float* scr = (LAS float*)(lds + wid * 16384); (void)misc; (void)xres; (void)lane; (void)gw; (void)NGW; (void)gt; (void)ngt; (void)scr;
#define PH_BEGIN if (ph >= P.ph_lo && ph < P.ph_hi) { OPAQUE
#define PH_END } ++ph;
#define PH_END_IF(c) } ++ph;
#else
#define OPAQUE unsigned char* ws = ws_; float* xres = xres_; int tid = threadIdx.x; int bx = bx_, G = G_; size_t zopq = 0; asm volatile("" : "+s"(zopq), "+v"(tid), "+s"(bx), "+s"(G)); ws += zopq; xres += zopq; float* misc = (float*)(ws + WS_MISC); \
    const int lane = tid & 63, wid = __builtin_amdgcn_readfirstlane(tid >> 6); const int gw = bx * 8 + wid, NGW = G * 8; const size_t gt = (size_t)bx * 512 + tid, ngt = (size_t)G * 512; \
    LAS float* scr = (LAS float*)(lds + wid * 16384); (void)misc; (void)xres; (void)lane; (void)gw; (void)NGW; (void)gt; (void)ngt; (void)scr;
#define PH_END_IF(c) if (c) xcd_barrier(xbar); } ++ph;
#define PH_BEGIN { OPAQUE
#define PH_END xcd_barrier(xbar); } ++ph;
#endif

    for (int layer = 0; layer < 2; ++layer) {
        const float* w1 = as_global(P.in[I_MW1]) + (size_t)layer * DM * DFF; const float* w2 = as_global(P.in[I_MW2]) + (size_t)layer * DFF * DM;
        const float* wg = as_global(P.in[I_PWG]) + (size_t)layer * DM * DM; const float* wp = as_global(P.in[I_PWP]) + (size_t)layer * PLE * DM;
        const float* pin = as_global(P.in[I_P]) + (size_t)layer * S * PLE;
        if (layer == 0) {
            PH_BEGIN
                convert_mat(as_global(P.in[I_AWQKV]), DM, 9216, (bf16_t*)(ws + W_QKV), scr, gw, NGW, lane);
                convert_mat(as_global(P.in[I_AWO]), DM, DM, (bf16_t*)(ws + W_O), scr, gw, NGW, lane);
                convert_mat(w1, DM, DFF, (bf16_t*)(ws + W_1), scr, gw, NGW, lane);
                convert_mat(w2, DFF, DM, (bf16_t*)(ws + W_2), scr, gw, NGW, lane);
                convert_mat(wg, DM, DM, (bf16_t*)(ws + W_G), scr, gw, NGW, lane);
                convert_mat(wp, PLE, DM, (bf16_t*)(ws + W_P), scr, gw, NGW, lane);
                convert_flat(pin, (bf16_t*)(ws + WS_PB), (size_t)S * PLE / 8, gt, ngt);
                if (bx == 0 && wid == 0) { float mq = 0.f, mk = 0.f;
                    for (int i = lane; i < 192; i += 64) { mq = fmaxf(mq, fabsf(as_global(P.in[I_AQG])[i])); mk = fmaxf(mk, fabsf(as_global(P.in[I_AKG])[i])); }
                    mq = wave_max(mq); mk = wave_max(mk); if (lane == 0) misc[0] = 8.f * mq * mk * LOG2E * 1.02f; }
                norm_rows_d<4>(as_global(P.in[I_X]), as_global(P.in[I_ANORM]), (bf16_t*)(ws + WS_H), S, gw, NGW, lane);
            PH_END
            for (int g = 0; g < 3; ++g) {
                PH_BEGIN
                    pg8::Gemm gm{(const bf16_t*)(ws + WS_H), (const bf16_t*)(ws + W_QKV) + (size_t)g * 3072 * DM, S, 3072, DM};
                    pg8::StaticOrder so; so.init(S, 3072, G, bx);
                    EpiBf16<0> E{(bf16_t*)(ws + WS_QKV), 3072, 2 * g, S, 0, nullptr, 0};
                    pg8::gemm_phase<EpiBf16<0>, pg8::StaticOrder>(lds, tid, gm, so, E);
                PH_END
                PH_BEGIN
                    attn_phase(lds, tid, (const bf16_t*)(ws + WS_QKV), g, (float*)(ws + WS_NACC), (float*)(ws + WS_Z), (bf16_t*)(ws + WS_H), as_global(P.in[I_AQG]), as_global(P.in[I_AKG]), misc[0]);
                PH_END
            }
            PH_BEGIN
                pg8::Gemm gm{(const bf16_t*)(ws + WS_H), (const bf16_t*)(ws + W_O), S, DM, DM};
                pg8::StaticOrder so; so.init(S, DM, G, bx);
                EpiF32<1> E{xres, as_global(P.in[I_X]), nullptr, DM};
                pg8::gemm_phase<EpiF32<1>, pg8::StaticOrder>(lds, tid, gm, so, E);
            PH_END
        } else {
            PH_BEGIN
                convert_mat_np(as_global(P.in[I_BWUP]), DM, 2 * BIN, (bf16_t*)(ws + W_UP), scr, gw, NGW, lane);
                convert_mat_np(as_global(P.in[I_BWDOWN]), BIN, DM, (bf16_t*)(ws + W_DOWN), scr, gw, NGW, lane);
                if (bx == 0) { for (int i = tid; i < 3 * BIN / 8; i += 512) ((u32x4*)(ws + WS_XM))[i] = (u32x4){0u, 0u, 0u, 0u}; }
                if (bx == 1 % G) m2_fold(tid, as_global(P.in[I_BWQ]), as_global(P.in[I_BWK]), as_global(P.in[I_BWV]), as_global(P.in[I_BWG]), misc + MS_GFOLD / 4);
                norm_rows(xres, as_global(P.in[I_BNORM]), (bf16_t*)(ws + WS_HSEG), SEG, gw, NGW, lane);
            PH_END
            PH_BEGIN
                pg8::Gemm gm{(const bf16_t*)(ws + WS_HSEG), (const bf16_t*)(ws + W_UP), SEG, 2 * BIN, DM};
                pg8::StaticOrder so; so.init(SEG, 2 * BIN, G, bx);
                EpiBf16<0> E{(bf16_t*)(ws + WS_XM) + 3 * BIN, BIN, 0, SEG, 8, (bf16_t*)(ws + WS_ZG), 0};
                pg8::gemm_phase<EpiBf16<0>, pg8::StaticOrder>(lds, tid, gm, so, E);
            PH_END
            for (int seg = 0; seg < NSEG; ++seg) {
                PH_BEGIN
                    m2_phase(lds, tid, bx, G, seg, (const bf16_t*)(ws + WS_XM), (bf16_t*)(ws + WS_XC), (bf16_t*)(ws + WS_QB), (bf16_t*)(ws + WS_KB), (bf16_t*)(ws + WS_VB), misc + MS_IPRE / 4, misc + MS_LOGF / 4,
                             as_global(P.in[I_BCW]), as_global(P.in[I_BCB]), as_global(P.in[I_BWQ]), as_global(P.in[I_BWK]), as_global(P.in[I_BWV]), misc + MS_GFOLD / 4, as_global(P.in[I_BBG]));
                PH_END
                PH_BEGIN
                    if (seg + 1 < NSEG) norm_rows(xres + (size_t)(seg + 1) * SEG * DM, as_global(P.in[I_BNORM]), (bf16_t*)(ws + WS_HSEG), SEG, gw, NGW, lane);
                    m3_phase(lds, tid, bx, G, seg, (const bf16_t*)(ws + WS_KB), (const bf16_t*)(ws + WS_VB), misc + MS_IPRE / 4, misc + MS_LOGF / 4,
                             (bf16_t*)(ws + WS_ST), misc + MS_NST / 4, misc + MS_MPREV / 4, misc + MS_MCARRY / 4, (float*)(ws + WS_CARRY), misc + MS_NCARRY / 4);
                    if (seg + 1 < NSEG && bx == G - 1) { for (int i = tid; i < 3 * BIN / 8; i += 512) ((u32x4*)(ws + WS_XM))[i] = ((const u32x4*)(ws + WS_XM + (size_t)SEG * BIN * 2))[i]; }
                PH_END
                PH_BEGIN
                    m4_phase(lds, tid, bx, G, seg, (const bf16_t*)(ws + WS_QB), (const bf16_t*)(ws + WS_KB), (const bf16_t*)(ws + WS_VB), (const bf16_t*)(ws + WS_XC), (bf16_t*)(ws + WS_ZG), misc + MS_IPRE / 4, misc + MS_LOGF / 4,
                             (const bf16_t*)(ws + WS_ST), misc + MS_NST / 4, misc + MS_MPREV / 4, as_global(P.in[I_BHG]), as_global(P.in[I_BSKIP]));
                    if (seg + 1 < NSEG) {
                        __syncthreads();
                        pg8::Gemm gm{(const bf16_t*)(ws + WS_HSEG), (const bf16_t*)(ws + W_UP), SEG, 2 * BIN, DM};
                        pg8::StaticOrder so; so.init(SEG, 2 * BIN, G, bx);
                        EpiBf16<0> E{(bf16_t*)(ws + WS_XM) + 3 * BIN, BIN, 0, SEG, 8, (bf16_t*)(ws + WS_ZG) + (size_t)(seg + 1) * SEG * BIN, 0};
                        pg8::gemm_phase<EpiBf16<0>, pg8::StaticOrder>(lds, tid, gm, so, E);
                    }
                PH_END
            }
            PH_BEGIN
                pg8::Gemm gm{(const bf16_t*)(ws + WS_ZG), (const bf16_t*)(ws + W_DOWN), S, DM, BIN};
                pg8::StaticOrder so; so.init(S, DM, G, bx);
                EpiF32<1> E{xres, xres, nullptr, DM};
                pg8::gemm_phase<EpiF32<1>, pg8::StaticOrder>(lds, tid, gm, so, E);
            PH_END
        }
        PH_BEGIN
            if (layer == 1) {
                convert_mat_np(w1, DM, DFF, (bf16_t*)(ws + W_1), scr, gw, NGW, lane);
                convert_mat_np(w2, DFF, DM, (bf16_t*)(ws + W_2), scr, gw, NGW, lane);
                convert_mat_np(wg, DM, DM, (bf16_t*)(ws + W_G), scr, gw, NGW, lane);
                convert_mat_np(wp, PLE, DM, (bf16_t*)(ws + W_P), scr, gw, NGW, lane);
                convert_flat(pin, (bf16_t*)(ws + WS_PB), (size_t)S * PLE / 8, gt, ngt);
            }
            norm_rows_d<4>(xres, as_global(P.in[I_MNORM]) + layer * DM, (bf16_t*)(ws + WS_H), S, gw, NGW, lane);
        PH_END
        PH_BEGIN
            pg8::Gemm gm{(const bf16_t*)(ws + WS_H), (const bf16_t*)(ws + W_1), S, DFF, DM};
            pg8::StaticOrder so; so.init(S, DFF, G, bx);
            EpiBf16<1> E{(bf16_t*)(ws + WS_HID), DFF, 0, S, 0, nullptr, 0};
            pg8::gemm_phase<EpiBf16<1>, pg8::StaticOrder>(lds, tid, gm, so, E);
        PH_END
        PH_BEGIN
            pg8::Gemm gm{(const bf16_t*)(ws + WS_HID), (const bf16_t*)(ws + W_2), S, DM, DFF};
            pg8::StaticOrder so; so.init(S, DM, G, bx);
            EpiF32<1> E{xres, xres, nullptr, DM};
            pg8::gemm_phase<EpiF32<1>, pg8::StaticOrder>(lds, tid, gm, so, E);
        PH_END
        PH_BEGIN
            norm_rows_d<4>(xres, as_global(P.in[I_PNORM]) + layer * DM, (bf16_t*)(ws + WS_H), S, gw, NGW, lane);
        PH_END
        PH_BEGIN
            {   pg8::Gemm gm{(const bf16_t*)(ws + WS_PB), (const bf16_t*)(ws + W_P), S, DM, PLE};
                pg8::StaticOrder so; so.init(S, DM, G, bx);
                EpiBf16<0> E{(bf16_t*)(ws + WS_PE), DM, 0, S, 0, nullptr, 0};
                pg8::gemm_phase<EpiBf16<0>, pg8::StaticOrder>(lds, tid, gm, so, E); }
            {   pg8::Gemm gm{(const bf16_t*)(ws + WS_H), (const bf16_t*)(ws + W_G), S, DM, DM};
                pg8::StaticOrder so; so.init(S, DM, G, bx);
                EpiF32<2> E{xres, xres, (const float*)(ws + WS_PE), DM};
                pg8::gemm_phase<EpiF32<2>, pg8::StaticOrder>(lds, tid, gm, so, E); }
        PH_END_IF(layer == 0)
    }
}

constexpr int NPHASES = 1 + 6 + 1 + 5 + 15 + 5;

extern "C" void kernel_launch(void* const* d_in, const int* in_sizes, int n_in, void* d_out, int out_size, void* d_ws, size_t ws_size, hipStream_t stream) {
    static int grid = 0;
    if (grid == 0) {
        if (n_in != 25 || ws_size < WS_END) { fprintf(stderr, "kernel_launch: unexpected n_in %d / ws %zu\n", n_in, ws_size); grid = -1; return; }
        int dev = 0, cus = 0, per_cu = 0;
        hipGetDevice(&dev); hipDeviceGetAttribute(&cus, hipDeviceAttributeMultiprocessorCount, dev);
        hipFuncSetAttribute((const void*)mega, hipFuncAttributeMaxDynamicSharedMemorySize, LDS_BYTES);
        hipOccupancyMaxActiveBlocksPerMultiprocessor(&per_cu, (const void*)mega, 512, LDS_BYTES);
        if (per_cu < 1) { fprintf(stderr, "kernel_launch: occupancy query says %d blocks/CU\n", per_cu); per_cu = 1; }
        (void)hipGetLastError();
        grid = cus * 1;
    }
    if (grid < 0) return;
    Params p{};
    for (int i = 0; i < 25; ++i) p.in[i] = (const float*)d_in[i];
    p.out = (float*)d_out; p.ws = (unsigned char*)d_ws;
#if MULTI_LAUNCH
    for (int ph = 0; ph < NPHASES; ++ph) { p.ph_lo = ph; p.ph_hi = ph + 1; hipLaunchKernelGGL(mega, dim3(grid), dim3(512), LDS_BYTES, stream, p); }
#else
    p.ph_lo = 0; p.ph_hi = NPHASES;
    if (hipMemsetAsync((unsigned char*)d_ws + WS_MISC + MS_BAR, 0, XCD_BAR_WORDS * 4, stream) != hipSuccess) { fprintf(stderr, "kernel_launch: memset of the barrier words failed\n"); return; }
    void* args[] = {&p};
    hipError_t e = hipLaunchCooperativeKernel((const void*)mega, dim3(grid), dim3(512), args, LDS_BYTES, stream);
    if (e != hipSuccess) fprintf(stderr, "cooperative launch failed: %s (grid %d)\n", hipGetErrorString(e), grid);
#endif
}
```
